# Optimizing an MI355X kernel written in HIP

```python
import math
import jax, jax.numpy as jnp
from jax import lax
import numpy as np

D_MODEL = 1024
BATCH = 1
SEQ = 16384
DEPTH = 4

N_A = DEPTH // 2
PLE_DIM = 256
NORM_EPS = 1e-6
L2_EPS = 1e-6
GDN_QK_HEADS = 8
GDN_V_HEADS = 16
GDN_HEAD_DIM = 128
GDN_CONV = 4
GDN_CHUNK = 64
GDN_QK_W = GDN_QK_HEADS * GDN_HEAD_DIM
GDN_V_W = GDN_V_HEADS * GDN_HEAD_DIM
GDN_CONV_W = 2 * GDN_QK_W + GDN_V_W
GDN_IN_W = GDN_CONV_W + GDN_V_W + 2 * GDN_V_HEADS
NSA_HEADS = 16
NSA_GROUPS = 4
NSA_HEAD_DIM = 64
NSA_REP = NSA_HEADS // NSA_GROUPS
CMP_BLOCK = 32
CMP_STRIDE = 16
CMP_HIDDEN = 256
SEL_BLOCK = 64
SEL_TOPK = 16
WINDOW = 512
Q_BLOCK = 128
FORCED_SCORE = 1e4
NSA_Q_W = NSA_HEADS * NSA_HEAD_DIM
NSA_QG_W = NSA_Q_W + 3 * NSA_HEADS
NSA_KV_W = 6 * NSA_GROUPS * NSA_HEAD_DIM
FFN_HIDDEN = ((8 * D_MODEL + 3 * 256 - 1) // (3 * 256)) * 256

kernel_name = "yoco_gdn_nsa_hybrid"


def rms_norm(x, g):
    xf = x.astype(jnp.float32)
    y = xf * lax.rsqrt(jnp.mean(xf * xf, axis=-1, keepdims=True) + NORM_EPS)
    return (y * g.astype(jnp.float32)).astype(x.dtype)


def l2_normalize(x):
    xf = x.astype(jnp.float32)
    return xf * lax.rsqrt(jnp.sum(xf * xf, axis=-1, keepdims=True) + L2_EPS)


def causal_short_conv(x, w):
    k_w, t = w.shape[0], x.shape[1]
    xp = jnp.pad(x, ((0, 0), (k_w - 1, 0), (0, 0)))
    y = xp[:, 0:t] * w[0]
    for j in range(1, k_w):
        y = y + xp[:, j:j + t] * w[j]
    return jax.nn.silu(y)


def chunk_gated_delta_rule(q, k, v, g, beta):
    f32 = jnp.float32
    b, t, h, dk = q.shape
    dv = v.shape[-1]
    c = GDN_CHUNK
    n = t // c

    def chunks(a):
        a = a.astype(f32).reshape((b, n, c, h) + a.shape[3:])
        return jnp.moveaxis(a, 3, 1)

    qc = chunks(q) * (dk ** -0.5)
    kc, vc, gc, bc = chunks(k), chunks(v), chunks(g), chunks(beta)
    gcum = jnp.cumsum(gc, axis=-1)
    causal = jnp.tril(jnp.ones((c, c), dtype=bool))
    strict = jnp.tril(jnp.ones((c, c), dtype=bool), k=-1)
    decay = jnp.exp(jnp.where(causal, gcum[..., :, None] - gcum[..., None, :], -jnp.inf))
    kb = kc * bc[..., None]
    a_mat = jnp.where(strict, jnp.einsum('bhncd,bhnsd->bhncs', kb, kc) * decay, 0.0) + jnp.eye(c, dtype=f32)
    rhs = jnp.concatenate([vc * bc[..., None], kb * jnp.exp(gcum)[..., None]], axis=-1)
    sol = lax.linalg.triangular_solve(a_mat, rhs, left_side=True, lower=True, unit_diagonal=True)
    u, w = sol[..., :dv], sol[..., dv:]
    qk = jnp.einsum('bhncd,bhnsd->bhncs', qc, kc) * decay
    q_dec = qc * jnp.exp(gcum)[..., None]
    g_last = gcum[..., -1]
    k_dec = kc * jnp.exp(g_last[..., None] - gcum)[..., None]

    def step(state, xs):
        u_i, w_i, qk_i, qd_i, kd_i, gl_i = xs
        v_new = u_i - jnp.einsum('bhcd,bhde->bhce', w_i, state)
        o_i = jnp.einsum('bhcd,bhde->bhce', qd_i, state) + jnp.einsum('bhcs,bhse->bhce', qk_i, v_new)
        state = state * jnp.exp(gl_i)[..., None, None] + jnp.einsum('bhcd,bhce->bhde', kd_i, v_new)
        return state, o_i

    xs = tuple(jnp.moveaxis(a, 2, 0) for a in (u, w, qk, q_dec, k_dec, g_last))
    s0 = jnp.zeros((b, h, dk, dv), f32)
    _, o = lax.scan(step, s0, xs)
    return jnp.transpose(o, (1, 0, 3, 2, 4)).reshape(b, t, h, dv)


def gated_deltanet(h, w_in, conv_w, a_log, dt_bias, o_norm, w_out):
    f32 = jnp.float32
    b, t, _ = h.shape
    proj = h @ w_in
    qkv, z, beta_logit, a = jnp.split(
        proj, [GDN_CONV_W, GDN_CONV_W + GDN_V_W, GDN_CONV_W + GDN_V_W + GDN_V_HEADS], axis=-1)
    qkv = causal_short_conv(qkv, conv_w)
    q, k, v = jnp.split(qkv, [GDN_QK_W, 2 * GDN_QK_W], axis=-1)
    rep = GDN_V_HEADS // GDN_QK_HEADS
    q = jnp.repeat(l2_normalize(q.reshape(b, t, GDN_QK_HEADS, GDN_HEAD_DIM)), rep, axis=2)
    k = jnp.repeat(l2_normalize(k.reshape(b, t, GDN_QK_HEADS, GDN_HEAD_DIM)), rep, axis=2)
    v = v.reshape(b, t, GDN_V_HEADS, GDN_HEAD_DIM)
    beta = jax.nn.sigmoid(beta_logit.astype(f32))
    g = -jnp.exp(a_log.astype(f32)) * jax.nn.softplus(a.astype(f32) + dt_bias.astype(f32))
    o = chunk_gated_delta_rule(q, k, v, g, beta)
    o = rms_norm(o, o_norm) * jax.nn.silu(z.reshape(b, t, GDN_V_HEADS, GDN_HEAD_DIM).astype(f32))
    return o.reshape(b, t, GDN_V_W).astype(h.dtype) @ w_out


def compress_blocks(x_raw, pos, w1, w2):
    b, g, t, d = x_raw.shape
    n_c = (t - CMP_BLOCK) // CMP_STRIDE + 1
    idx = CMP_STRIDE * jnp.arange(n_c)[:, None] + jnp.arange(CMP_BLOCK)[None, :]
    blocks = x_raw[:, :, idx] + pos
    flat = blocks.reshape(b, g, n_c, CMP_BLOCK * d)
    return jax.nn.silu(flat @ w1) @ w2


def nsa_shared_kv(h, kv_norm, kv_w, cmp_pos, cmp_w1, cmp_w2):
    b, t, _ = h.shape
    kv = rms_norm(h, kv_norm) @ kv_w
    kv = jnp.transpose(kv.reshape(b, t, 6, NSA_GROUPS, NSA_HEAD_DIM), (2, 0, 3, 1, 4))
    k_c = compress_blocks(kv[0], cmp_pos[0], cmp_w1[0], cmp_w2[0])
    v_c = compress_blocks(kv[1], cmp_pos[1], cmp_w1[1], cmp_w2[1])
    return k_c, v_c, kv[2], kv[3], kv[4], kv[5]


def masked_softmax(s, mask):
    s = jnp.where(mask, s.astype(jnp.float32), -jnp.inf)
    m = jnp.max(s, axis=-1, keepdims=True)
    m = jnp.where(jnp.isfinite(m), m, 0.0)
    e = jnp.where(mask, jnp.exp(s - m), 0.0)
    return e / jnp.maximum(jnp.sum(e, axis=-1, keepdims=True), 1e-30)


def selection_importance(p_cmp, n_sel):
    r = SEL_BLOCK // CMP_STRIDE
    c = CMP_BLOCK // CMP_STRIDE
    n_c = p_cmp.shape[-1]
    pp = jnp.pad(p_cmp, [(0, 0)] * (p_cmp.ndim - 1) + [(c - 1, r * n_sel - n_c)])
    out = jnp.zeros(p_cmp.shape[:-1] + (n_sel,), p_cmp.dtype)
    for m in range(r):
        for n in range(c):
            off = m - n + c - 1
            out = out + pp[..., off:off + r * n_sel:r]
    return out


def nsa_attention(h, w_qg, w_o, k_cmp, v_cmp, k_slc, v_slc, k_win, v_win):
    b, t, _ = h.shape
    G, R, Dh = NSA_GROUPS, NSA_REP, NSA_HEAD_DIM
    qg = h @ w_qg
    q = qg[..., :NSA_Q_W].reshape(b, t, G, R, Dh) * (Dh ** -0.5)
    gates = jax.nn.sigmoid(qg[..., NSA_Q_W:].astype(jnp.float32)).reshape(b, t, G, R, 3)
    n_c = k_cmp.shape[2]
    n_sel = t // SEL_BLOCK
    topk = min(SEL_TOPK, n_sel)
    cmp_end = CMP_STRIDE * jnp.arange(n_c) + CMP_BLOCK - 1
    blk = jnp.arange(n_sel)
    k_sel_blocks = k_slc.reshape(b, G, n_sel, SEL_BLOCK, Dh)
    v_sel_blocks = v_slc.reshape(b, G, n_sel, SEL_BLOCK, Dh)
    k_win_p = jnp.pad(k_win, ((0, 0), (0, 0), (WINDOW, 0), (0, 0)))
    v_win_p = jnp.pad(v_win, ((0, 0), (0, 0), (WINDOW, 0), (0, 0)))
    b_idx = jnp.arange(b)[:, None, None, None]
    g_idx = jnp.arange(G)[None, :, None, None]

    def query_block(i):
        s = i * Q_BLOCK
        qb = lax.dynamic_slice_in_dim(q, s, Q_BLOCK, axis=1)
        gb = lax.dynamic_slice_in_dim(gates, s, Q_BLOCK, axis=1)
        tq = s + jnp.arange(Q_BLOCK)
        sc = jnp.einsum('bqgrd,bgnd->bgrqn', qb, k_cmp)
        p_c = masked_softmax(sc, cmp_end[None, :] <= tq[:, None])
        o_c = jnp.einsum('bgrqn,bgnd->bqgrd', p_c, v_cmp)
        imp = selection_importance(jnp.sum(p_c, axis=2), n_sel)
        cur = tq // SEL_BLOCK
        forced = (blk[None, :] == 0) | (blk[None, :] == cur[:, None]) | (blk[None, :] == cur[:, None] - 1)
        valid = blk[None, :] * SEL_BLOCK <= tq[:, None]
        score = jnp.where(valid, jnp.where(forced, FORCED_SCORE, imp), -jnp.inf)
        _, sel = lax.top_k(score, topk)
        ks = k_sel_blocks[b_idx, g_idx, sel]
        vs = v_sel_blocks[b_idx, g_idx, sel]
        key_pos = sel[..., None] * SEL_BLOCK + jnp.arange(SEL_BLOCK)
        m_s = (key_pos <= tq[None, None, :, None, None]).reshape(b, G, 1, Q_BLOCK, topk * SEL_BLOCK)
        ss = jnp.einsum('bqgrd,bgqkld->bgrqkl', qb, ks).reshape(b, G, R, Q_BLOCK, topk * SEL_BLOCK)
        p_s = masked_softmax(ss, m_s).reshape(b, G, R, Q_BLOCK, topk, SEL_BLOCK)
        o_s = jnp.einsum('bgrqkl,bgqkld->bqgrd', p_s, vs)
        kw = lax.dynamic_slice_in_dim(k_win_p, s, Q_BLOCK + WINDOW, axis=2)
        vw = lax.dynamic_slice_in_dim(v_win_p, s, Q_BLOCK + WINDOW, axis=2)
        wpos = s - WINDOW + jnp.arange(Q_BLOCK + WINDOW)
        m_w = (wpos[None, :] >= 0) & (wpos[None, :] <= tq[:, None]) & (wpos[None, :] > tq[:, None] - WINDOW)
        sw = jnp.einsum('bqgrd,bgkd->bgrqk', qb, kw)
        o_w = jnp.einsum('bgrqk,bgkd->bqgrd', masked_softmax(sw, m_w), vw)
        return gb[..., 0:1] * o_c + gb[..., 1:2] * o_s + gb[..., 2:3] * o_w

    o = lax.map(query_block, jnp.arange(t // Q_BLOCK))
    o = jnp.moveaxis(o, 0, 1).reshape(b, t, NSA_Q_W).astype(h.dtype)
    return o @ w_o


def swiglu(h, w_in, w_out):
    gate, up = jnp.split(h @ w_in, 2, axis=-1)
    return (jax.nn.silu(gate) * up) @ w_out


def setup_inputs(seed: int = 0) -> dict:
    key = jax.random.key(seed)
    ks = jax.random.split(key, 24)
    f32 = jnp.float32
    n_b = DEPTH - N_A

    def nrm(k, shape, fan_in):
        return jax.random.normal(k, shape, f32) * (fan_in ** -0.5)

    def gain(k, shape):
        return 1.0 + 0.05 * jax.random.normal(k, shape, f32)

    dt = jnp.exp(jax.random.uniform(ks[10], (N_A, GDN_V_HEADS), f32, math.log(1e-3), math.log(1e-1)))
    return {
        "x": jax.random.normal(ks[0], (BATCH, SEQ, D_MODEL), f32),
        "p": jax.random.normal(ks[1], (DEPTH, BATCH, SEQ, PLE_DIM), f32),
        "mix_pre_norm": gain(ks[2], (DEPTH, D_MODEL)),
        "mix_post_norm": gain(ks[3], (DEPTH, D_MODEL)),
        "ffn_pre_norm": gain(ks[4], (DEPTH, D_MODEL)),
        "ffn_post_norm": gain(ks[5], (DEPTH, D_MODEL)),
        "gdn_w_in": nrm(ks[6], (N_A, D_MODEL, GDN_IN_W), D_MODEL),
        "gdn_conv_w": nrm(ks[7], (N_A, GDN_CONV, GDN_CONV_W), GDN_CONV),
        "gdn_a_log": jnp.log(jax.random.uniform(ks[8], (N_A, GDN_V_HEADS), f32, 1.0, 16.0)),
        "gdn_dt_bias": dt + jnp.log(-jnp.expm1(-dt)),
        "gdn_o_norm": gain(ks[9], (N_A, GDN_HEAD_DIM)),
        "gdn_w_out": nrm(ks[11], (N_A, GDN_V_W, D_MODEL), GDN_V_W),
        "kv_norm": gain(ks[12], (D_MODEL,)),
        "kv_w": nrm(ks[13], (D_MODEL, NSA_KV_W), D_MODEL),
        "cmp_pos": 0.1 * jax.random.normal(ks[14], (2, CMP_BLOCK, NSA_HEAD_DIM), f32),
        "cmp_w1": nrm(ks[15], (2, CMP_BLOCK * NSA_HEAD_DIM, CMP_HIDDEN), CMP_BLOCK * NSA_HEAD_DIM),
        "cmp_w2": nrm(ks[16], (2, CMP_HIDDEN, NSA_HEAD_DIM), CMP_HIDDEN),
        "nsa_w_qg": nrm(ks[17], (n_b, D_MODEL, NSA_QG_W), D_MODEL),
        "nsa_w_o": nrm(ks[18], (n_b, NSA_Q_W, D_MODEL), NSA_Q_W),
        "ffn_w_in": nrm(ks[19], (DEPTH, D_MODEL, 2 * FFN_HIDDEN), D_MODEL),
        "ffn_w_out": nrm(ks[20], (DEPTH, FFN_HIDDEN, D_MODEL), FFN_HIDDEN),
        "ple_w_in": nrm(ks[21], (DEPTH, PLE_DIM, D_MODEL), PLE_DIM),
        "ple_w_gate": nrm(ks[22], (DEPTH, D_MODEL, D_MODEL), D_MODEL),
    }


def reference(x, p, mix_pre_norm, mix_post_norm, ffn_pre_norm, ffn_post_norm,
              gdn_w_in, gdn_conv_w, gdn_a_log, gdn_dt_bias, gdn_o_norm, gdn_w_out,
              kv_norm, kv_w, cmp_pos, cmp_w1, cmp_w2, nsa_w_qg, nsa_w_o,
              ffn_w_in, ffn_w_out, ple_w_in, ple_w_gate):
    def channel_and_ple(h, i):
        f = swiglu(rms_norm(h, ffn_pre_norm[i]), ffn_w_in[i], ffn_w_out[i])
        h = h + rms_norm(f, ffn_post_norm[i])
        return h + (p[i] @ ple_w_in[i]) * jax.nn.sigmoid(h @ ple_w_gate[i])

    h = x
    for i in range(N_A):
        mix = gated_deltanet(rms_norm(h, mix_pre_norm[i]), gdn_w_in[i], gdn_conv_w[i], gdn_a_log[i],
                             gdn_dt_bias[i], gdn_o_norm[i], gdn_w_out[i])
        h = h + rms_norm(mix, mix_post_norm[i])
        h = channel_and_ple(h, i)
    k_cmp, v_cmp, k_slc, v_slc, k_win, v_win = nsa_shared_kv(h, kv_norm, kv_w, cmp_pos, cmp_w1, cmp_w2)
    for i in range(N_A, DEPTH):
        j = i - N_A
        mix = nsa_attention(rms_norm(h, mix_pre_norm[i]), nsa_w_qg[j], nsa_w_o[j],
                            k_cmp, v_cmp, k_slc, v_slc, k_win, v_win)
        h = h + rms_norm(mix, mix_post_norm[i])
        h = channel_and_ple(h, i)
    return h
```

```cpp
#include <hip/hip_runtime.h>
#include <hip/hip_cooperative_groups.h>
#include <cstdio>
#include <cstdint>
namespace cg = cooperative_groups;
#define GRID_SYNC() do { asm volatile("s_waitcnt vmcnt(0) lgkmcnt(0)" ::: "memory"); cg::this_grid().sync(); } while (0)

#define LAS __attribute__((address_space(3)))
typedef unsigned short bf16_t;
typedef short bf16x8 __attribute__((ext_vector_type(8)));
typedef float f32x4 __attribute__((ext_vector_type(4)));
typedef float f32x2 __attribute__((ext_vector_type(2)));
typedef unsigned u32x4 __attribute__((ext_vector_type(4)));
typedef unsigned u32x2 __attribute__((ext_vector_type(2)));

constexpr int T = 16384, D = 1024, PLE = 256, FF = 2816;
constexpr int NWAVES = 8, NTHREADS = 512;
constexpr float EPS = 1e-6f;
constexpr size_t MiB = (size_t)1 << 20;
constexpr size_t WS_SSY = 0, WS_SSH1 = 65536, WS_SSH2 = 131072, WS_BIAS1 = 196608;
constexpr size_t WS_SSO = 1 * MiB, WS_BG = 2 * MiB, WS_SSYP = 4 * MiB, WS_SSH2P = 5 * MiB;
constexpr size_t WS_W = 8 * MiB;
constexpr size_t WS_HBA = 44 * MiB, WS_HBB = 76 * MiB, WS_RA = 108 * MiB, WS_RB = 236 * MiB, WS_END = 364 * MiB;
constexpr size_t W_WIN = 0, W_WZ = 9 * MiB, W_WOUT = 13 * MiB, W_FFNIN = 17 * MiB, W_FFNOUT = 28 * MiB, W_PLE = 33 * MiB + MiB / 2, W_GATE = 34 * MiB;
constexpr size_t W_WQ = 0, W_WO = 3 * MiB, W_WK = 5 * MiB, W_WV = 7 * MiB, W_W1T = 8 * MiB, W_W2T = 10 * MiB;
constexpr size_t RB_Y = 0, RB_KBUF = 64 * MiB, RB_VT = 96 * MiB, RB_HID = 112 * MiB, RB_KC = 116 * MiB, RB_VCT = 118 * MiB, RB_PB = 120 * MiB;
constexpr int VT_LD = T + 64;
constexpr size_t RA_VT = 96 * MiB;
constexpr int LDS_TBL = 141312;
constexpr int LDS_XB = 141312 + 256;
constexpr int LDS_BYTES = 141312 + 256 + 64;
constexpr size_t WS_XBAR = 212992;
constexpr int NSA_WAVE_LDS = 17664;

template <class Tp> __device__ __forceinline__ Tp* lau(Tp* p) { asm volatile("" : "+s"(p)); return p; }
__device__ __forceinline__ int lauv0() { int v = 0; asm volatile("" : "+v"(v)); return v; }
__device__ __forceinline__ int my_lane() { return (int)__builtin_amdgcn_mbcnt_hi(~0u, __builtin_amdgcn_mbcnt_lo(~0u, (unsigned)lauv0())); }
__device__ __forceinline__ int hw_slot() { return (int)(__builtin_amdgcn_s_getreg((5 << 11) | 4) & 0x3Fu); }
__device__ __forceinline__ int my_wave(LAS unsigned char* lds) { return __builtin_amdgcn_readfirstlane(((LAS int*)(lds + LDS_TBL))[hw_slot()]); }
__device__ __forceinline__ int lauv(int v) { asm volatile("" : "+v"(v)); return v; }
__device__ __forceinline__ int laus(int v) { asm volatile("" : "+s"(v)); return v; }
__device__ __forceinline__ unsigned cvt_pk_bf16(float lo, float hi) { unsigned r; asm volatile("v_cvt_pk_bf16_f32 %0, %1, %2" : "=v"(r) : "v"(lo), "v"(hi)); return r; }
__device__ __forceinline__ float bf2f(unsigned short b) { return __uint_as_float((unsigned)b << 16); }
__device__ __forceinline__ void st_bf4(bf16_t* p, f32x4 v) { u32x2 w; w.x = cvt_pk_bf16(v[0], v[1]); w.y = cvt_pk_bf16(v[2], v[3]); *(u32x2*)p = w; }
__device__ __forceinline__ f32x4 ld_bf4(const bf16_t* p) { u32x2 w = *(const u32x2*)p; f32x4 r; r[0] = __uint_as_float(w.x << 16); r[1] = __uint_as_float(w.x & 0xffff0000u); r[2] = __uint_as_float(w.y << 16); r[3] = __uint_as_float(w.y & 0xffff0000u); return r; }
__device__ __forceinline__ float sigmoidf_(float x) { return __builtin_amdgcn_rcpf(1.f + __builtin_amdgcn_exp2f(x * -1.44269504f)); }
__device__ __forceinline__ float siluf_(float x) { return x * __builtin_amdgcn_rcpf(1.f + __builtin_amdgcn_exp2f(x * -1.44269504f)); }
__device__ __forceinline__ float shx(float v, int o, int lane) { return __builtin_bit_cast(float, __builtin_amdgcn_ds_bpermute((lane ^ o) << 2, __builtin_bit_cast(int, v))); }
template <int CTRL> __device__ __forceinline__ float dpp_f(float v) { return __builtin_bit_cast(float, __builtin_amdgcn_update_dpp(__builtin_bit_cast(int, v), __builtin_bit_cast(int, v), CTRL, 0xf, 0xf, false)); }
template <int CTRL> __device__ __forceinline__ unsigned dpp_u(unsigned v) { return (unsigned)__builtin_amdgcn_update_dpp((int)v, (int)v, CTRL, 0xf, 0xf, false); }
__device__ __forceinline__ float row_sum16(float v) { v += dpp_f<0xB1>(v); v += dpp_f<0x4E>(v); v += dpp_f<0x141>(v); v += dpp_f<0x140>(v); return v; }
__device__ __forceinline__ unsigned umax_(unsigned a, unsigned b) { return a > b ? a : b; }
__device__ __forceinline__ float readlane_f(float v, int l) { return __builtin_bit_cast(float, __builtin_amdgcn_readlane(__builtin_bit_cast(int, v), l)); }
__device__ __forceinline__ float wave_sum(float v) { v = row_sum16(v); return readlane_f(v, 0) + readlane_f(v, 16) + readlane_f(v, 32) + readlane_f(v, 48); }
__device__ __forceinline__ unsigned wave_max_u32(unsigned v) {
    v = umax_(v, dpp_u<0xB1>(v)); v = umax_(v, dpp_u<0x4E>(v)); v = umax_(v, dpp_u<0x141>(v)); v = umax_(v, dpp_u<0x140>(v));
    const unsigned a = (unsigned)__builtin_amdgcn_readlane((int)v, 0), b = (unsigned)__builtin_amdgcn_readlane((int)v, 16), c = (unsigned)__builtin_amdgcn_readlane((int)v, 32), d = (unsigned)__builtin_amdgcn_readlane((int)v, 48);
    return umax_(umax_(a, b), umax_(c, d));
}

namespace pg8 {
constexpr int BM = 256, BK = 64, HALF = 128, HTB = HALF * BK * 2, STAGE_BYTES = 8 * HTB, NXCD = 8, WGM = 8;
__host__ __device__ __forceinline__ int lds_byte(int r, int c) { const int st = (r >> 4) * 2 + (c >> 5), rr = r & 15, cc = c & 31, ob = rr * 64 + cc * 2; return st * 1024 + (ob ^ (((ob >> 9) & 1) << 5)); }
__host__ __device__ __forceinline__ void stage_rc(int b, int& R, int& C) { const int st = b / 1024, sb = b % 1024, swz = sb ^ (((sb >> 9) & 1) << 5); R = (st >> 1) * 16 + swz / 64; C = (st & 1) * 32 + (swz % 64) / 2; }
struct Unit { int pm, pn; };
struct Gemm { const bf16_t* A; const bf16_t* Bt; int M, N, K, lda, ldb; };
struct StaticOrder {
    int nM, nN, nwg, G, c;
    __device__ void init(int M, int N, int G_, int c_) { nM = M / BM; nN = N / BM; nwg = nM * nN; G = G_; c = c_; }
    __device__ bool next(int i, Unit& u) const {
        const long L = (long)i * G + c; if (L >= nwg) return false;
        int wgid = (int)L; { const int q = nwg / NXCD, r = nwg % NXCD, xcd = wgid % NXCD, off = wgid / NXCD; wgid = (xcd < r ? xcd * (q + 1) : r * (q + 1) + (xcd - r) * q) + off; }
        const int nig = WGM * nN, gid = wgid / nig, fm = gid * WGM, gsz = (nM - fm) < WGM ? (nM - fm) : WGM;
        u.pm = fm + ((wgid % nig) % gsz); u.pn = (wgid % nig) / gsz; return true;
    }
};
template <class F> struct EpiFn {
    F f;
    __device__ __forceinline__ void operator()(const f32x4 (&acc)[2][2][4][2], const Unit& u, int wr, int wc, int fr, int fq) const {
#pragma unroll
        for (int ai = 0; ai < 2; ++ai)
#pragma unroll
            for (int m = 0; m < 4; ++m) { const int row = u.pm * BM + ai * HALF + wr * 64 + m * 16 + fr;
#pragma unroll
                for (int bj = 0; bj < 2; ++bj) f(row, u.pn * BM + bj * HALF + wc * 32 + 4 * fq, acc[ai][bj][m][0], acc[ai][bj][m][1]); }
    }
};
template <class G> struct EpiSS {
    G g; float* Y; float* ss; int ldc;
    __device__ __forceinline__ void operator()(const f32x4 (&acc)[2][2][4][2], const Unit& u, int wr, int wc, int fr, int fq) const {
#pragma unroll
        for (int ai = 0; ai < 2; ++ai)
#pragma unroll
            for (int m = 0; m < 4; ++m) { const int row = u.pm * BM + ai * HALF + wr * 64 + m * 16 + fr; float s = 0.f;
#pragma unroll
                for (int bj = 0; bj < 2; ++bj) { const int cb = u.pn * BM + bj * HALF + wc * 32 + 4 * fq; f32x4 o0 = acc[ai][bj][m][0], o1 = acc[ai][bj][m][1];
                    g(row, cb, o0, o1);
                    *(f32x4*)(Y + (size_t)row * ldc + cb) = o0; *(f32x4*)(Y + (size_t)row * ldc + cb + 16) = o1;
                    s += (o0[0] * o0[0] + o0[1] * o0[1]) + (o0[2] * o0[2] + o0[3] * o0[3]) + (o1[0] * o1[0] + o1[1] * o1[1]) + (o1[2] * o1[2] + o1[3] * o1[3]); }
                s += shx(s, 16, fq * 16 + fr); s += shx(s, 32, fq * 16 + fr);
                if (fq == 0) ss[(size_t)row * 16 + u.pn * 4 + wc] = s; }
    }
};

template <class Epi>
__device__ __forceinline__ void gemm_phase(LAS unsigned char* lds, const Gemm g, const StaticOrder& S, const Epi& E) {
    const int lane = lauv(my_lane()), wid = laus(my_wave(lds)), tid = wid * 64 + lane, wr = wid >> 2, wc = wid & 3, fr = lane & 15, fq = lane >> 4;
    const int K = g.K, nt = K / BK;
    unsigned voffA[2], voffB[2];
#pragma unroll
    for (int i = 0; i < 2; ++i) { int R, C; stage_rc(tid * 16 + i * 8192, R, C);
        voffA[i] = (unsigned)(R * g.lda + C) * 2u; voffB[i] = (unsigned)(R * g.ldb + C) * 2u; }
    const size_t kstep = (size_t)(BK * 2);
    const size_t hA = (size_t)HALF * g.lda * 2, hB = (size_t)HALF * g.ldb * 2;
    const size_t tA = 2 * hA, tB = 2 * hB;
    const unsigned ldsw = (unsigned)wid * 1024u;
    const int aoff = lds_byte(wr * 64 + fr, fq * 8), boff = lds_byte(wc * 32 + fr, fq * 8);
#define PG8_SA(b, h) (((b) * 2 + (h)) * HTB)
#define PG8_SB(b, h) ((4 + (b) * 2 + (h)) * HTB)
#define PG8_STAGE(bufoff, gbase, voff) do { _Pragma("unroll") for (int _i = 0; _i < 2; ++_i) \
        __builtin_amdgcn_global_load_lds((const unsigned*)((const char*)(gbase) + (voff)[_i]), (LAS unsigned*)(lds + (bufoff) + ldsw + _i * 8192), 16, 0, 0); } while (0)
#define PG8_LDA(dst, b, h) do { _Pragma("unroll") for (int m = 0; m < 4; ++m) _Pragma("unroll") for (int k = 0; k < 2; ++k) dst[m][k] = *(const LAS bf16x8*)(lds + PG8_SA(b, h) + aoff + m * 2048 + k * 1024); } while (0)
#define PG8_LDB(dst, b, h) do { _Pragma("unroll") for (int n = 0; n < 2; ++n) _Pragma("unroll") for (int k = 0; k < 2; ++k) dst[n][k] = *(const LAS bf16x8*)(lds + PG8_SB(b, h) + boff + n * 2048 + k * 1024); } while (0)
#define PG8_MMA(ai, bj, At, Bt) do { __builtin_amdgcn_s_setprio(1); _Pragma("unroll") for (int m = 0; m < 4; ++m) _Pragma("unroll") for (int n = 0; n < 2; ++n) _Pragma("unroll") for (int k = 0; k < 2; ++k) \
        acc[ai][bj][m][n] = __builtin_amdgcn_mfma_f32_16x16x32_bf16(Bt[n][k], At[m][k], acc[ai][bj][m][n], 0, 0, 0); __builtin_amdgcn_s_setprio(0); } while (0)
#define PG8_WAIT_V(n) asm volatile("s_waitcnt vmcnt(" #n ")" ::: "memory")
#define PG8_WAIT_L(n) asm volatile("s_waitcnt lgkmcnt(" #n ")" ::: "memory")
#define PG8_BAR __builtin_amdgcn_s_barrier()
#define PG8_SCHED __builtin_amdgcn_sched_barrier(0)
    Unit cur, nxt; int ui = 0;
    if (!S.next(0, cur)) return;
    f32x4 acc[2][2][4][2];
#pragma unroll
    for (int a = 0; a < 2; ++a)
#pragma unroll
        for (int b = 0; b < 2; ++b)
#pragma unroll
            for (int m = 0; m < 4; ++m)
#pragma unroll
                for (int n = 0; n < 2; ++n) acc[a][b][m][n] = (f32x4){0.f, 0.f, 0.f, 0.f};
    bf16x8 At[4][2], B0[2][2], B1[2][2];
    const char* cA = (const char*)g.A + (size_t)cur.pm * tA; const char* cB = (const char*)g.Bt + (size_t)cur.pn * tB;
    PG8_STAGE(PG8_SB(0, 0), cB, voffB); PG8_STAGE(PG8_SB(0, 1), cB + hB, voffB); PG8_STAGE(PG8_SA(0, 0), cA, voffA); PG8_STAGE(PG8_SA(0, 1), cA + hA, voffA);
    if (wr == 1) PG8_BAR;
    PG8_WAIT_V(2); PG8_BAR;
    PG8_STAGE(PG8_SB(1, 0), cB + kstep, voffB); PG8_STAGE(PG8_SA(1, 0), cA + kstep, voffA); PG8_STAGE(PG8_SB(1, 1), cB + hB + kstep, voffB);
    PG8_WAIT_V(6); PG8_BAR;
    for (;;) {
        const bool has_next = S.next(ui + 1, nxt);
        const char* nA = has_next ? (const char*)g.A + (size_t)nxt.pm * tA : cA; const char* nB = has_next ? (const char*)g.Bt + (size_t)nxt.pn * tB : cB;
        for (int t = 0; t < nt; t += 2) {
            const bool last = (t == nt - 2);
            const char* a1 = cA + (size_t)(t + 1) * kstep;
            const char* a2 = last ? nA : cA + (size_t)(t + 2) * kstep; const char* b2 = last ? nB : cB + (size_t)(t + 2) * kstep;
            const char* a3 = a2 + kstep; const char* b3 = b2 + kstep;
            PG8_LDB(B0, 0, 0); PG8_LDB(B1, 0, 1); PG8_SCHED; PG8_LDA(At, 0, 0); PG8_STAGE(PG8_SA(1, 1), a1 + hA, voffA);
            PG8_WAIT_V(8); PG8_WAIT_L(0); PG8_BAR; PG8_MMA(0, 0, At, B0); PG8_MMA(0, 1, At, B1); PG8_BAR; PG8_SCHED;
            PG8_LDA(At, 0, 1); PG8_STAGE(PG8_SB(0, 0), b2, voffB); PG8_STAGE(PG8_SB(0, 1), b2 + hB, voffB); PG8_STAGE(PG8_SA(0, 0), a2, voffA);
            PG8_WAIT_V(8); PG8_WAIT_L(0); PG8_BAR; PG8_MMA(1, 0, At, B0); PG8_MMA(1, 1, At, B1); PG8_BAR; PG8_SCHED;
            PG8_LDB(B0, 1, 0); PG8_LDB(B1, 1, 1); PG8_SCHED; PG8_LDA(At, 1, 0); PG8_STAGE(PG8_SA(0, 1), a2 + hA, voffA);
            PG8_WAIT_V(8); PG8_WAIT_L(0); PG8_BAR; PG8_MMA(0, 0, At, B0); PG8_MMA(0, 1, At, B1); PG8_BAR; PG8_SCHED;
            PG8_LDA(At, 1, 1); PG8_STAGE(PG8_SB(1, 0), b3, voffB); PG8_STAGE(PG8_SB(1, 1), b3 + hB, voffB); PG8_STAGE(PG8_SA(1, 0), a3, voffA);
            PG8_WAIT_V(8); PG8_WAIT_L(0); PG8_BAR; PG8_MMA(1, 0, At, B0); PG8_MMA(1, 1, At, B1); PG8_BAR; PG8_SCHED;
        }
        if (wr == 0) PG8_BAR;
        { const int l2 = lauv(my_lane()), w2 = laus(my_wave(lds)); E(acc, cur, w2 >> 2, w2 & 3, l2 & 15, l2 >> 4); }
        if (!has_next) break;
#pragma unroll
        for (int a = 0; a < 2; ++a)
#pragma unroll
            for (int b = 0; b < 2; ++b)
#pragma unroll
                for (int m = 0; m < 4; ++m)
#pragma unroll
                    for (int n = 0; n < 2; ++n) acc[a][b][m][n] = (f32x4){0.f, 0.f, 0.f, 0.f};
        cur = nxt; cA = nA; cB = nB; ++ui;
        if (wr == 1) PG8_BAR;
    }
    PG8_WAIT_V(0);
    PG8_BAR;
#undef PG8_SA
#undef PG8_SB
#undef PG8_STAGE
#undef PG8_LDA
#undef PG8_LDB
#undef PG8_MMA
#undef PG8_WAIT_V
#undef PG8_WAIT_L
#undef PG8_BAR
#undef PG8_SCHED
}
}

struct Params {
    const float *x, *p, *mix_pre, *mix_post, *ffn_pre, *ffn_post, *gdn_w_in, *gdn_conv_w, *gdn_a_log, *gdn_dt_bias, *gdn_o_norm, *gdn_w_out,
        *kv_norm, *kv_w, *cmp_pos, *cmp_w1, *cmp_w2, *nsa_w_qg, *nsa_w_o, *ffn_w_in, *ffn_w_out, *ple_w_in, *ple_w_gate;
    float* out; unsigned char* ws;
};
typedef const __attribute__((address_space(4))) Params* KP;


#define XB_TMO      128
#define XB_XCNT(j)  (256  + 64 * (j))
#define XB_XSUB(j)  (1280 + 64 * (j))
#define XB_XGEN(j)  (2304 + 64 * (j))
#define XB_TOP      3328
#define XB_TOPGEN   3392
#define XB_SPIN_CAP (1u << 22)
__device__ __forceinline__ unsigned xb_ld(unsigned* p)              { return __hip_atomic_load(p, __ATOMIC_RELAXED, __HIP_MEMORY_SCOPE_AGENT); }
__device__ __forceinline__ unsigned xb_add(unsigned* p, unsigned v) { return __hip_atomic_fetch_add(p, v, __ATOMIC_RELAXED, __HIP_MEMORY_SCOPE_AGENT); }
__device__ __forceinline__ unsigned xb_xcc_id() { return (unsigned)__builtin_amdgcn_s_getreg((3 << 11) | 20) & 0xFu; }
#define XB_SPIN(cond, bar) do { unsigned _sp = 0; while (cond) { __builtin_amdgcn_s_sleep(1); \
    if ((++_sp & 255u) == 0u) { if (xb_ld(&(bar)[XB_TMO])) break; if (_sp > XB_SPIN_CAP) { atomicAdd(&(bar)[XB_TMO], 1u); break; } } } } while (0)
__device__ __forceinline__ void xcd_barrier_complete(unsigned* bar, unsigned x, unsigned& nloc, unsigned& nx) {
    const unsigned Gn = gridDim.x;
    unsigned sum, cnt, mine, sp = 0u;
    for (;;) {
        sum = 0u; cnt = 0u; mine = 0u;
#pragma unroll
        for (unsigned j = 0; j < 16; ++j) { const unsigned c = xb_ld(&bar[XB_XCNT(j)]); sum += c; cnt += (c > 0u) ? 1u : 0u; mine = (j == x) ? c : mine; }
        if (sum == Gn) break;
        __builtin_amdgcn_s_sleep(1);
        if ((++sp & 255u) == 0u) { if (xb_ld(&bar[XB_TMO])) break; if (sp > XB_SPIN_CAP) { atomicAdd(&bar[XB_TMO], 1u); break; } }
    }
    nloc = mine > 0u ? mine : 1u; nx = cnt > 0u ? cnt : 1u;
}
__device__ __forceinline__ void xcd_grid_barrier(KP P, LAS unsigned char* lds) {
    asm volatile("s_waitcnt vmcnt(0) lgkmcnt(0)" ::: "memory");
    __syncthreads();
    if (laus(my_wave(lds)) == 0 && lauv(my_lane()) == 0) {
        unsigned* bar = (unsigned*)(lau(lau(P)->ws) + WS_XBAR);
        volatile LAS unsigned* st = (volatile LAS unsigned*)(lds + LDS_XB);
        const unsigned x = xb_xcc_id();
        __builtin_amdgcn_s_waitcnt(0);
        const unsigned nloc = st[0], nx = st[1];
        const unsigned old = xb_add(&bar[XB_XSUB(x)], 1u);
        const unsigned gen = old / nloc;
        if (old + 1u == (gen + 1u) * nloc) {
            __builtin_amdgcn_fence(__ATOMIC_RELEASE, "agent");
            asm volatile("s_waitcnt vmcnt(0)" ::: "memory");
            const unsigned og = xb_add(&bar[XB_TOP], 1u);
            const unsigned tg = og / nx;
            if (og + 1u == (tg + 1u) * nx) xb_add(&bar[XB_TOPGEN], 1u);
            else XB_SPIN(xb_ld(&bar[XB_TOPGEN]) == tg, bar);
            __builtin_amdgcn_fence(__ATOMIC_ACQUIRE, "agent");
            xb_add(&bar[XB_XGEN(x)], 1u);
            asm volatile("s_waitcnt vmcnt(0)" ::: "memory");
        } else {
            XB_SPIN(xb_ld(&bar[XB_XGEN(x)]) == gen, bar);
            __builtin_amdgcn_fence(__ATOMIC_ACQUIRE, "agent");
            asm volatile("s_waitcnt vmcnt(0)" ::: "memory");
        }
    }
    __syncthreads();
}

__device__ __forceinline__ int ffn_row(int n) { const int up = n >= FF ? 1 : 0, hid = n - up * FF; const int pn = hid >> 7, r = hid & 127; return 256 * pn + 128 * (r >> 6) + 32 * ((r & 63) >> 4) + 16 * up + (r & 15); }
__device__ __noinline__ int cv_job_(const float* W, int K, int N, int n_lo, int n_hi, const float* gain, bf16_t* WT, int row_off, int mode, LAS float* scr, int gw, int ngw, int base, int lane, float mul) {
    const int nblk = (n_hi - n_lo + 31) / 32, items = (K / 64) * nblk;
    int first = (gw - base % ngw + ngw) % ngw;
    for (int it = first; it < items; it += ngw) {
        const int kb = it / nblk, nb = it % nblk, k0 = 64 * kb, n0 = n_lo + 32 * nb;
#pragma unroll 32
        for (int i = 0; i < 32; ++i) { const int kk = 2 * i + (lane >> 5), n = n0 + (lane & 31); float v = (n < n_hi) ? W[(size_t)(k0 + kk) * N + n] : 0.f; if (gain) v *= gain[k0 + kk]; scr[kk * 33 + (lane & 31)] = v * mul; }
        asm volatile("s_waitcnt lgkmcnt(0)" ::: "memory");
        const int c = lane & 7;
#pragma unroll
        for (int j = 0; j < 4; ++j) { const int nl = (lane >> 3) + 8 * j, n = n0 + nl; const LAS float* s = scr + (8 * c) * 33 + nl;
            u32x4 o; o.x = cvt_pk_bf16(s[0 * 33], s[1 * 33]); o.y = cvt_pk_bf16(s[2 * 33], s[3 * 33]); o.z = cvt_pk_bf16(s[4 * 33], s[5 * 33]); o.w = cvt_pk_bf16(s[6 * 33], s[7 * 33]);
            if (n < n_hi) { const int row = mode ? ffn_row(n) : row_off + (n - n_lo); *(u32x4*)(WT + (size_t)row * K + k0 + 8 * c) = o; } }
        asm volatile("s_waitcnt lgkmcnt(0)" ::: "memory");
    }
    return base + items;
}
#define cv_job(W_, K_, N_, lo_, hi_, g_, WT_, ro_, mode_, scr_, gw_, ngw_, base_, lane_, ...) base_ = cv_job_(W_, K_, N_, lo_, hi_, g_, WT_, ro_, mode_, scr_, gw_, ngw_, base_, lane_, (1.f, ##__VA_ARGS__))
__device__ __forceinline__ void zero_bf16(bf16_t* p, size_t n, int gtid, int gthreads) {
    const unsigned z = (unsigned)lauv(0);
    for (size_t i = (size_t)gtid * 8; i < n; i += (size_t)gthreads * 8) *(u32x4*)(p + i) = (u32x4){z, z, z, z};
}

__device__ __forceinline__ void convert_layer(KP P, int li, LAS unsigned char* lds) {
    P = lau(P);
    const int lane = lauv(my_lane()), wave = laus(my_wave(lds)), ngw = gridDim.x * NWAVES, gw = blockIdx.x * NWAVES + wave;
    LAS float* scr = (LAS float*)(lds + wave * 16384);
    unsigned char* wb = lau(lau(P)->ws) + WS_W;
    int base = 0;
    const int gtid = gw * 64 + lane, gthreads = ngw * 64;
    if (li < 2) {
        const float* win = P->gdn_w_in + (size_t)li * D * 6176; const float* gain = P->mix_pre + li * D;
        cv_job(win, D, 6176, 0, 4096, gain, (bf16_t*)(wb + W_WIN), 0, 0, scr, gw, ngw, base, lane);
        cv_job(win, D, 6176, 4096, 6144, gain, (bf16_t*)(wb + W_WZ), 0, 0, scr, gw, ngw, base, lane);
        cv_job(win, D, 6176, 6144, 6176, gain, (bf16_t*)(wb + W_WIN), 4096, 0, scr, gw, ngw, base, lane);
        zero_bf16((bf16_t*)(wb + W_WIN) + (size_t)4128 * D, (size_t)(4352 - 4128) * D, gtid, gthreads);
        cv_job(P->gdn_w_out + (size_t)li * 2048 * D, 2048, D, 0, D, nullptr, (bf16_t*)(wb + W_WOUT), 0, 0, scr, gw, ngw, base, lane);
    } else {
        const int j = li - 2;
        cv_job(P->nsa_w_qg + (size_t)j * D * 1072, D, 1072, 0, 1024, P->mix_pre + li * D, (bf16_t*)(wb + W_WQ), 0, 0, scr, gw, ngw, base, lane, 0.125f);
        cv_job(P->nsa_w_qg + (size_t)j * D * 1072, D, 1072, 1024, 1072, P->mix_pre + li * D, (bf16_t*)(wb + W_WQ), 1024, 0, scr, gw, ngw, base, lane);
        zero_bf16((bf16_t*)(wb + W_WQ) + (size_t)1072 * D, (size_t)(1280 - 1072) * D, gtid, gthreads);
        cv_job(P->nsa_w_o + (size_t)j * D * D, D, D, 0, D, nullptr, (bf16_t*)(wb + W_WO), 0, 0, scr, gw, ngw, base, lane);
        if (li == 2) {
            bf16_t* wk = (bf16_t*)(wb + W_WK); bf16_t* wv = (bf16_t*)(wb + W_WV);
            cv_job(P->kv_w, D, 1536, 0, 768, P->kv_norm, wk, 0, 0, scr, gw, ngw, base, lane);
            cv_job(P->kv_w, D, 1536, 768, 1024, P->kv_norm, wv, 0, 0, scr, gw, ngw, base, lane);
            cv_job(P->kv_w, D, 1536, 1024, 1280, P->kv_norm, wk, 768, 0, scr, gw, ngw, base, lane);
            cv_job(P->kv_w, D, 1536, 1280, 1536, P->kv_norm, wv, 256, 0, scr, gw, ngw, base, lane);
            for (int idx = 0; idx < 2; ++idx) {
                cv_job(P->cmp_w1 + (size_t)idx * 2048 * 256, 2048, 256, 0, 256, nullptr, (bf16_t*)(wb + W_W1T) + (size_t)idx * 256 * 2048, 0, 0, scr, gw, ngw, base, lane);
                cv_job(P->cmp_w2 + (size_t)idx * 256 * 64, 256, 64, 0, 64, nullptr, (bf16_t*)(wb + W_W2T) + (size_t)idx * 256 * 256, 0, 0, scr, gw, ngw, base, lane);
                zero_bf16((bf16_t*)(wb + W_W2T) + (size_t)idx * 256 * 256 + 64 * 256, (size_t)192 * 256, gtid, gthreads);
            }
        }
    }
    cv_job(P->ffn_w_in + (size_t)li * D * 2 * FF, D, 2 * FF, 0, 2 * FF, P->ffn_pre + li * D, (bf16_t*)(wb + W_FFNIN), 0, 1, scr, gw, ngw, base, lane);
    cv_job(P->ffn_w_out + (size_t)li * FF * D, FF, D, 0, D, nullptr, (bf16_t*)(wb + W_FFNOUT), 0, 0, scr, gw, ngw, base, lane);
    cv_job(P->ple_w_in + (size_t)li * PLE * D, PLE, D, 0, D, nullptr, (bf16_t*)(wb + W_PLE), 0, 0, scr, gw, ngw, base, lane);
    cv_job(P->ple_w_gate + (size_t)li * D * D, D, D, 0, D, nullptr, (bf16_t*)(wb + W_GATE), 0, 0, scr, gw, ngw, base, lane);
}
__device__ __forceinline__ void cmp_bias(KP P, LAS unsigned char* lds) {
    P = lau(P);
    const int lane = lauv(my_lane()), wave = laus(my_wave(lds));
    if (blockIdx.x >= 2) return;
    const int idx = blockIdx.x;
    const float* w1 = P->cmp_w1 + (size_t)idx * 2048 * 256; const float* pos = P->cmp_pos + idx * 2048;
    f32x4 a = (f32x4){0.f, 0.f, 0.f, 0.f};
    for (int k = wave * 256; k < wave * 256 + 256; ++k) { const f32x4 w = *(const f32x4*)(w1 + (size_t)k * 256 + lane * 4); a += w * pos[k]; }
    LAS f32x4* part = (LAS f32x4*)lds;
    __syncthreads();
    part[wave * 64 + lane] = a;
    __syncthreads();
    if (wave == 0) { f32x4 s = part[lane]; for (int w = 1; w < 8; ++w) s += part[w * 64 + lane]; *(f32x4*)((float*)(lau(lau(P)->ws) + WS_BIAS1) + idx * 256 + lane * 4) = s; }
    __syncthreads();
}

__device__ __forceinline__ void rows_phase(KP P, int mode, int li, bf16_t* hb, const float* gpost, const float* Y, LAS unsigned char* lds) {
    P = lau(P);
    const int lane = lauv(my_lane()), wave = laus(my_wave(lds)), ngw = gridDim.x * NWAVES, gw = blockIdx.x * NWAVES + wave;
    unsigned char* ws = lau(lau(P)->ws);
    float* ssh1 = (float*)(ws + WS_SSH1); float* ssh2 = (float*)(ws + WS_SSH2);
    for (int r = gw; r < T; r += ngw) {
        f32x4 h[4]; float s = 0.f;
        if (mode == 0) {
#pragma unroll
            for (int j = 0; j < 4; ++j) h[j] = *(const f32x4*)(P->x + (size_t)r * D + 4 * lane + 256 * j);
        } else {
            float ssv = ((const float*)(ws + WS_SSYP))[(size_t)r * 16 + (lane & 15)]; ssv = row_sum16(ssv);
            const float rr = rsqrtf(ssv * (1.f / D) + EPS);
#pragma unroll
            for (int j = 0; j < 4; ++j) { const int c = 4 * lane + 256 * j; const f32x4 y = *(const f32x4*)(Y + (size_t)r * D + c), g = *(const f32x4*)(gpost + c), h0 = *(const f32x4*)(P->out + (size_t)r * D + c); h[j] = h0 + y * rr * g; }
        }
#pragma unroll
        for (int j = 0; j < 4; ++j) { const int c = 4 * lane + 256 * j; *(f32x4*)(P->out + (size_t)r * D + c) = h[j]; st_bf4(hb + (size_t)r * D + c, h[j]);
            s += (h[j][0] * h[j][0] + h[j][1] * h[j][1]) + (h[j][2] * h[j][2] + h[j][3] * h[j][3]); }
        s = wave_sum(s);
        if (lane == 0) { if (mode == 0) ssh2[r] = s; else if (mode == 1) ssh1[r] = s; }
        if (mode == 2) { const f32x4 pv = *(const f32x4*)(P->p + ((size_t)li * T + r) * PLE + 4 * lane); st_bf4((bf16_t*)(ws + WS_RB + RB_PB) + (size_t)r * PLE + 4 * lane, pv); }
    }
}

__device__ __forceinline__ bf16x8 ldg16(const bf16_t* p) { return *(const bf16x8*)p; }
__device__ __forceinline__ bf16x8 pack8(const f32x4& a, const f32x4& b) { u32x4 w; w.x = cvt_pk_bf16(a[0], a[1]); w.y = cvt_pk_bf16(a[2], a[3]); w.z = cvt_pk_bf16(b[0], b[1]); w.w = cvt_pk_bf16(b[2], b[3]); return __builtin_bit_cast(bf16x8, w); }
#define MFMA16(a, b, c) __builtin_amdgcn_mfma_f32_16x16x32_bf16((a), (b), (c), 0, 0, 0)

__device__ __forceinline__ void gdn_conv_phase(KP P, int li, LAS unsigned char* lds) {
    P = lau(P);
    const int lane = lauv(my_lane()), wave = laus(my_wave(lds)), ngw = gridDim.x * NWAVES, gw = blockIdx.x * NWAVES + wave;
    unsigned char* ws = lau(lau(P)->ws);
    const bf16_t* src = (const bf16_t*)(ws + WS_RA); bf16_t* dst = (bf16_t*)(ws + WS_RB);
    float* bg = (float*)(ws + WS_BG);
    const float* cw = P->gdn_conv_w + (size_t)li * 4 * 4096;
    for (int rb = gw; rb < T / 8; rb += ngw) {
        const int t0 = rb * 8;
        for (int ci = 0; ci < 8; ++ci) {
            const int c0 = 512 * ci + 8 * lane;
            f32x4 w[4][2];
#pragma unroll
            for (int j = 0; j < 4; ++j) { w[j][0] = *(const f32x4*)(cw + j * 4096 + c0); w[j][1] = *(const f32x4*)(cw + j * 4096 + c0 + 4); }
            f32x4 xa[3][2];
#pragma unroll
            for (int j = 0; j < 3; ++j) { const int t = t0 - 3 + j;
                if (t >= 0) { xa[j][0] = ld_bf4(src + (size_t)t * 4096 + c0); xa[j][1] = ld_bf4(src + (size_t)t * 4096 + c0 + 4); } else { xa[j][0] = (f32x4){0.f, 0.f, 0.f, 0.f}; xa[j][1] = xa[j][0]; } }
#pragma unroll
            for (int tt = 0; tt < 8; ++tt) { const int t = t0 + tt;
                f32x4 x3[2]; x3[0] = ld_bf4(src + (size_t)t * 4096 + c0); x3[1] = ld_bf4(src + (size_t)t * 4096 + c0 + 4);
                f32x4 y[2]; float ss = 0.f;
#pragma unroll
                for (int hh = 0; hh < 2; ++hh) { y[hh] = xa[0][hh] * w[0][hh] + xa[1][hh] * w[1][hh] + xa[2][hh] * w[2][hh] + x3[hh] * w[3][hh];
#pragma unroll
                    for (int e = 0; e < 4; ++e) { y[hh][e] = siluf_(y[hh][e]); ss += y[hh][e] * y[hh][e]; } }
                if (ci < 4) { ss = row_sum16(ss); float sc = rsqrtf(ss + 1e-6f); if (ci < 2) sc *= 0.08838834764831845f; y[0] = y[0] * sc; y[1] = y[1] * sc; }
                u32x4 o; o.x = cvt_pk_bf16(y[0][0], y[0][1]); o.y = cvt_pk_bf16(y[0][2], y[0][3]); o.z = cvt_pk_bf16(y[1][0], y[1][1]); o.w = cvt_pk_bf16(y[1][2], y[1][3]);
                *(u32x4*)(dst + (size_t)t * 4096 + c0) = o;
                xa[0][0] = xa[1][0]; xa[0][1] = xa[1][1]; xa[1][0] = xa[2][0]; xa[1][1] = xa[2][1]; xa[2][0] = x3[0]; xa[2][1] = x3[1]; }
        }
        if (lane < 16) {
            const float A = __expf(P->gdn_a_log[li * 16 + lane]), dtb = P->gdn_dt_bias[li * 16 + lane];
#pragma unroll
            for (int tt = 0; tt < 8; ++tt) { const int t = t0 + tt; const float bl = bg[t * 32 + lane], a = bg[t * 32 + 16 + lane] + dtb;
                const float sp = fmaxf(a, 0.f) + log1pf(__expf(-fabsf(a)));
                bg[t * 32 + lane] = sigmoidf_(bl); bg[t * 32 + 16 + lane] = -A * sp; }
        }
    }
}

__device__ __forceinline__ void gdn_scan_phase(KP P, LAS unsigned char* lds) {
    P = lau(P);
    const int lane = lauv(my_lane()), wave = laus(my_wave(lds));
    if (wave >= 2) return;
    const int id = blockIdx.x * 2 + wave; if (id >= 512) return;
    const int hv = id >> 5, cgp = id & 31, hq = hv >> 1, row = lane >> 4, part = lane & 15, e = 4 * cgp + row;
    unsigned char* ws = lau(lau(P)->ws);
    bf16_t* base = (bf16_t*)(ws + WS_RB);
    const bf16_t* qp = base + hq * 128 + 8 * part; const bf16_t* kp = base + 1024 + hq * 128 + 8 * part; bf16_t* vp = base + 2048 + hv * 128 + e;
    const float* ab = (const float*)(ws + WS_BG);
    float S[8];
#pragma unroll
    for (int i = 0; i < 8; ++i) S[i] = 0.f;
    u32x4 kr[2][4], qr[2][4]; unsigned short vr[2][4]; float be[2][4], al[2][4];
#define GS_LOAD(buf, tb) do { _Pragma("unroll") for (int u = 0; u < 4; ++u) { const size_t t = (size_t)((tb) + u); kr[buf][u] = *(const u32x4*)(kp + t * 4096); qr[buf][u] = *(const u32x4*)(qp + t * 4096); vr[buf][u] = vp[t * 4096]; be[buf][u] = ab[t * 32 + hv]; al[buf][u] = __expf(ab[t * 32 + 16 + hv]); } } while (0)
#define GS_COMP(buf, tb) do { _Pragma("unroll") for (int u = 0; u < 4; ++u) { const size_t t = (size_t)((tb) + u); \
        float kf[8], qf[8]; \
        _Pragma("unroll") for (int j = 0; j < 4; ++j) { kf[2 * j] = __uint_as_float(kr[buf][u][j] << 16); kf[2 * j + 1] = __uint_as_float(kr[buf][u][j] & 0xffff0000u); qf[2 * j] = __uint_as_float(qr[buf][u][j] << 16); qf[2 * j + 1] = __uint_as_float(qr[buf][u][j] & 0xffff0000u); } \
        float dot = 0.f; _Pragma("unroll") for (int i = 0; i < 8; ++i) dot += kf[i] * S[i]; \
        dot = row_sum16(dot); \
        const float a = al[buf][u], c = be[buf][u] * (bf2f(vr[buf][u]) - a * dot); \
        float od = 0.f; _Pragma("unroll") for (int i = 0; i < 8; ++i) { S[i] = a * S[i] + kf[i] * c; od += qf[i] * S[i]; } \
        od = row_sum16(od); \
        const unsigned ob = cvt_pk_bf16(od, od) & 0xffffu; \
        if (part == 0) vp[t * 4096] = (unsigned short)ob; } } while (0)
    GS_LOAD(0, 0);
    for (int tb = 0; tb < T; tb += 8) {
        GS_LOAD(1, tb + 4);
        GS_COMP(0, tb);
        if (tb + 8 < T) GS_LOAD(0, tb + 8);
        GS_COMP(1, tb + 4);
    }
#undef GS_LOAD
#undef GS_COMP
}


constexpr int GD_ITEM = 90112;
constexpr int GD_W = 0, GD_QD = 16384, GD_KDT = 32768, GD_QK = 49152, GD_U = 57344, GD_STEP = 57344;
constexpr size_t RA_SST = 120 * MiB;
constexpr int PREP_HALF_LDS = 53248;
constexpr int GD_WCH = 32, GD_NWIN = 256 / GD_WCH;
constexpr size_t GD_REGION = (size_t)16 * GD_WCH * GD_ITEM;
__device__ __forceinline__ int frag_off(int r, int c, int ksteps) { return (((r >> 4) * ksteps + (c >> 5)) * 64 + (((c & 15) >> 2) * 16) + (r & 15)) * 16 + (((c & 16) >> 2) + (c & 3)) * 2; }

__device__ __forceinline__ void gdn_prep_phase(KP P, int wi, LAS unsigned char* lds, int blk0, int nblk) {
    if ((int)blockIdx.x < blk0 || (int)blockIdx.x >= blk0 + nblk) return;
    P = lau(P);
    const int lane0 = lauv(my_lane()), wave = laus(my_wave(lds)), half = wave >> 2, w4 = wave & 3;
    unsigned char* ws = lau(P->ws);
    const bf16_t* qkv = (const bf16_t*)(ws + WS_RB); const float* ab = (const float*)(ws + WS_BG); float* glb = (float*)(ws + WS_SSY);
    unsigned char* items = ws + WS_RA + (size_t)(wi & 1) * GD_REGION;
    LAS unsigned char* hl = lds + half * PREP_HALF_LDS;
    LAS float* gcs = (LAS float*)hl; LAS float* bts = gcs + 64; LAS float* ebs = gcs + 128; LAS float* Lm = (LAS float*)(hl + 1024); LAS bf16_t* solb = (LAS bf16_t*)(hl + 1024 + 17408);
    const f32x4 z4 = (f32x4){0.f, 0.f, 0.f, 0.f};
    for (int it0 = ((int)blockIdx.x - blk0) * 2; it0 < 16 * GD_WCH; it0 += nblk * 2) {
        const int lane = lauv(lane0), tid4 = w4 * 64 + lane, fr = lane & 15, fq = lane >> 4;
        const int item = it0 + half, hv = item / GD_WCH, nl = item % GD_WCH, n = wi * GD_WCH + nl, t0 = n * 64, hq = hv >> 1;
        unsigned char* ib = items + (size_t)item * GD_ITEM;
        const bf16_t* qb = qkv + (size_t)t0 * 4096 + hq * 128; const bf16_t* kb = qb + 1024; const bf16_t* vb = qkv + (size_t)t0 * 4096 + 2048 + hv * 128;
        if (w4 == 0) { const float g = ab[(size_t)(t0 + lane) * 32 + 16 + hv]; bts[lane] = ab[(size_t)(t0 + lane) * 32 + hv]; gcs[lane] = g;
            asm volatile("s_waitcnt lgkmcnt(0)" ::: "memory");
            float sacc = 0.f;
            for (int i = 0; i < 64; ++i) { const float gi = gcs[i]; sacc += (i <= lane) ? gi : 0.f; }
            asm volatile("s_waitcnt lgkmcnt(0)" ::: "memory");
            gcs[lane] = sacc; ebs[lane] = bts[lane] * __expf(sacc);
            if (lane == 63) glb[hv * 256 + n] = __expf(sacc); }
        __syncthreads();
        { const int t = 16 * w4 + fr; const float gct = gcs[t], bt = bts[t];
          bf16x8 KT[4], QT[4];
#pragma unroll
          for (int kk = 0; kk < 4; ++kk) { KT[kk] = *(const bf16x8*)(kb + (size_t)t * 4096 + 32 * kk + 8 * fq); QT[kk] = *(const bf16x8*)(qb + (size_t)t * 4096 + 32 * kk + 8 * fq); }
          for (int nt = 0; nt < 4; ++nt) {
              f32x4 Lv = z4, qv = z4;
              if (nt <= w4) {
                  f32x4 aL = z4, aQ = z4;
#pragma unroll
                  for (int kk = 0; kk < 4; ++kk) { const bf16x8 X = *(const bf16x8*)(kb + (size_t)(16 * nt + fr) * 4096 + 32 * kk + 8 * fq); aL = MFMA16(X, KT[kk], aL); aQ = MFMA16(X, QT[kk], aQ); }
                  const f32x4 gs4 = *(const LAS f32x4*)(gcs + 16 * nt + 4 * fq);
#pragma unroll
                  for (int jj = 0; jj < 4; ++jj) { const int sx = 16 * nt + 4 * fq + jj; const float dec = __expf(gct - gs4[jj]); Lv[jj] = (sx < t) ? bt * aL[jj] * dec : 0.f; qv[jj] = (sx <= t) ? aQ[jj] * dec : 0.f; }
              }
              *(LAS f32x4*)(Lm + t * 68 + 16 * nt + 4 * fq) = Lv;
              st_bf4((bf16_t*)(ib + GD_QK + ((w4 * 2 + (nt >> 1)) * 64 + fq * 16 + fr) * 16 + (nt & 1) * 8), qv);
          } }
        { const float gl = gcs[63];
#pragma unroll
          for (int i = 0; i < 8; ++i) { const int p = tid4 + 256 * i, t = p >> 5, d4 = (p & 31) * 4; const float sc = __expf(gcs[t]);
              const f32x4 v = ld_bf4(qb + (size_t)t * 4096 + d4); st_bf4((bf16_t*)(ib + GD_QD + frag_off(t, d4, 4)), v * sc); }
#pragma unroll
          for (int i = 0; i < 8; ++i) { const int p = tid4 + 256 * i, dk = p & 127, t4 = (p >> 7) * 4; f32x4 v; const f32x4 gs4 = *(const LAS f32x4*)(gcs + t4);
#pragma unroll
              for (int e = 0; e < 4; ++e) v[e] = bf2f(kb[(size_t)(t4 + e) * 4096 + dk]) * __expf(gl - gs4[e]);
              st_bf4((bf16_t*)(ib + GD_KDT + frag_off(dk, t4, 2)), v); } }
        __syncthreads();
        { const int col = 64 * w4 + lane; float r[64];
          { const bf16_t* src = (w4 < 2) ? (vb + col) : (kb + col - 128); const LAS float* cf = (w4 < 2) ? bts : ebs;
#pragma unroll
            for (int i4 = 0; i4 < 16; ++i4) { const f32x4 c4 = *(const LAS f32x4*)(cf + 4 * i4);
#pragma unroll
                for (int e = 0; e < 4; ++e) r[4 * i4 + e] = bf2f(src[(size_t)(4 * i4 + e) * 4096]) * c4[e]; } }
#pragma unroll
          for (int i = 1; i < 64; ++i) {
#pragma unroll
              for (int j4 = 0; j4 < (i + 3) / 4; ++j4) { const f32x4 l = *(const LAS f32x4*)(Lm + i * 68 + 4 * j4);
#pragma unroll
                  for (int e = 0; e < 4; ++e) if (4 * j4 + e < i) r[i] -= l[e] * r[4 * j4 + e]; }
          }
#pragma unroll
          for (int i = 0; i < 64; ++i) solb[i * 264 + col] = (bf16_t)(cvt_pk_bf16(r[i], r[i]) & 0xffffu);
          if (w4 < 2) {
#pragma unroll
              for (int mt = 0; mt < 4; ++mt)
#pragma unroll
                  for (int q = 0; q < 4; ++q) *(f32x4*)(ib + GD_U + ((((col >> 4) * 4 + mt) * 64 + q * 16 + (col & 15)) * 16)) = (f32x4){r[16 * mt + 4 * q], r[16 * mt + 4 * q + 1], r[16 * mt + 4 * q + 2], r[16 * mt + 4 * q + 3]};
          }
        }
        __syncthreads();
#pragma unroll
        for (int i = 0; i < 8; ++i) { const int p = tid4 + 256 * i, t = p >> 5, d4 = (p & 31) * 4;
            *(u32x2*)(ib + GD_W + frag_off(t, d4, 4)) = *(const LAS u32x2*)(solb + t * 264 + 128 + d4); }
        __syncthreads();
    }
}

__device__ __forceinline__ void gdn_scan2_phase(KP P, int li, LAS unsigned char* lds) {
    P = lau(P);
    const int lane = lauv(my_lane()), wave = laus(my_wave(lds));
    if (wave != 0 || blockIdx.x >= 128) return;
    const int hv = blockIdx.x >> 3, slice = blockIdx.x & 7, fr = lane & 15, fq = lane >> 4;
    unsigned char* ws = lau(P->ws);
    unsigned* flags = (unsigned*)(ws + WS_XBAR + 16384) + (size_t)li * 16 * 64;
    const f32x4 z4 = (f32x4){0.f, 0.f, 0.f, 0.f};
    const float one = __builtin_bit_cast(float, lauv(0x3f800000));
    f32x4 Sacc[8]; bf16x8 Sop[4];
#pragma unroll
    for (int dt = 0; dt < 8; ++dt) Sacc[dt] = z4;
#pragma unroll
    for (int kk = 0; kk < 4; ++kk) Sop[kk] = pack8(Sacc[2 * kk], Sacc[2 * kk + 1]);
#define GS2_STAGE(slot, nl_) do { const unsigned char* gsrc = items + (size_t)(nl_) * GD_ITEM + lane * 16; \
        _Pragma("unroll") for (int f = 0; f < 56; ++f) __builtin_amdgcn_global_load_lds((const unsigned*)(gsrc + f * 1024), (LAS unsigned*)(lds + (slot) * GD_STEP + f * 1024), 16, 0, 0); } while (0)
#define GS2_LDU(dst, nl_) do { _Pragma("unroll") for (int mt = 0; mt < 4; ++mt) dst[mt] = *(const f32x4*)(items + (size_t)(nl_) * GD_ITEM + GD_U + ((slice * 4 + mt) * 64 + lane) * 16); } while (0)
    f32x4 ucur[4], unxt[4];
    for (int wi = 0; wi < GD_NWIN; ++wi) {
    const unsigned char* items = ws + WS_RA + (size_t)(wi & 1) * GD_REGION + (size_t)(hv * GD_WCH) * GD_ITEM; const float* glb = (const float*)(ws + WS_SSY) + hv * 256 + wi * GD_WCH;
    bf16_t* ob = (bf16_t*)(ws + WS_RB) + (size_t)(wi * GD_WCH * 64) * 4096 + 2048 + hv * 128 + slice * 16 + fr;
    { const unsigned want = (wi == 0) ? gridDim.x : gridDim.x - 128; unsigned sp = 0;
      while (__hip_atomic_load(flags + 64 * wi, __ATOMIC_RELAXED, __HIP_MEMORY_SCOPE_AGENT) < want) { __builtin_amdgcn_s_sleep(2); if (++sp > (1u << 22)) break; }
      __builtin_amdgcn_fence(__ATOMIC_ACQUIRE, "agent"); asm volatile("s_waitcnt vmcnt(0)" ::: "memory"); }
#ifndef GS2_DIRECT
    GS2_STAGE(0, 0);
#endif
    GS2_LDU(ucur, 0);
    asm volatile("s_waitcnt vmcnt(0)" ::: "memory");
    for (int nl = 0; nl < GD_WCH; ++nl) {
        asm volatile("s_waitcnt lgkmcnt(0)" ::: "memory");
#ifdef GS2_DIRECT
        if (nl + 1 < GD_WCH) { GS2_LDU(unxt, nl + 1); }
#else
        if (nl + 1 < GD_WCH) { GS2_STAGE((nl + 1) & 1, nl + 1); GS2_LDU(unxt, nl + 1); }
#endif
        const float egl = glb[nl];
#ifdef GS2_DIRECT
        const unsigned char* sb = items + (size_t)nl * GD_ITEM + lane * 16;
#define GS2_FR(off) (*(const bf16x8*)(sb + (off)))
#else
        const LAS unsigned char* sb = lds + (nl & 1) * GD_STEP + lane * 16;
#define GS2_FR(off) (*(const LAS bf16x8*)(sb + (off)))
#endif
        f32x4 vn[4];
#pragma unroll
        for (int mt = 0; mt < 4; ++mt) { f32x4 a = z4;
#pragma unroll
            for (int kk = 0; kk < 4; ++kk) a = MFMA16(GS2_FR(GD_W + (mt * 4 + kk) * 1024), Sop[kk], a);
            vn[mt] = ucur[mt] - a; }
        bf16x8 Vop[2]; Vop[0] = pack8(vn[0], vn[1]); Vop[1] = pack8(vn[2], vn[3]);
#pragma unroll
        for (int mt = 0; mt < 4; ++mt) { f32x4 a = z4;
#pragma unroll
            for (int kk = 0; kk < 4; ++kk) a = MFMA16(GS2_FR(GD_QD + (mt * 4 + kk) * 1024), Sop[kk], a);
#pragma unroll
            for (int k2 = 0; k2 < 2; ++k2) a = MFMA16(GS2_FR(GD_QK + (mt * 2 + k2) * 1024), Vop[k2], a);
            a = a * one;
#pragma unroll
            for (int jj = 0; jj < 4; ++jj) ob[(size_t)(nl * 64 + 16 * mt + 4 * fq + jj) * 4096] = (bf16_t)(cvt_pk_bf16(a[jj], a[jj]) & 0xffffu); }
#pragma unroll
        for (int dt = 0; dt < 8; ++dt) { f32x4 a = Sacc[dt] * egl;
#pragma unroll
            for (int k2 = 0; k2 < 2; ++k2) a = MFMA16(GS2_FR(GD_KDT + (dt * 2 + k2) * 1024), Vop[k2], a);
            Sacc[dt] = a; }
#pragma unroll
        for (int kk = 0; kk < 4; ++kk) Sop[kk] = pack8(Sacc[2 * kk] * one, Sacc[2 * kk + 1] * one);
        asm volatile("s_waitcnt vmcnt(0)" ::: "memory");
#pragma unroll
        for (int mt = 0; mt < 4; ++mt) ucur[mt] = unxt[mt];
    }
    if (lane == 0) (void)__hip_atomic_fetch_add(flags + 64 * (8 + wi), 1u, __ATOMIC_RELAXED, __HIP_MEMORY_SCOPE_AGENT);
    }
#undef GS2_STAGE
#undef GS2_LDU
}

__device__ __forceinline__ void gdn_prep_pipe(KP P, int li, LAS unsigned char* lds) {
    for (int w = 0; w < GD_NWIN; ++w) {
        if (w > 0 && (int)blockIdx.x < 128) break;
        unsigned* flags = (unsigned*)(lau(lau(P)->ws) + WS_XBAR + 16384) + (size_t)li * 16 * 64;
        if (w >= 2) { if (laus(my_wave(lds)) == 0 && lauv(my_lane()) == 0) { unsigned sp = 0;
                while (__hip_atomic_load(flags + 64 * (8 + w - 2), __ATOMIC_RELAXED, __HIP_MEMORY_SCOPE_AGENT) < 128u) { __builtin_amdgcn_s_sleep(2); if (++sp > (1u << 22)) break; } }
            __syncthreads(); }
        gdn_prep_phase(P, w, lds, w == 0 ? 0 : 128, w == 0 ? (int)gridDim.x : (int)gridDim.x - 128);
        asm volatile("s_waitcnt vmcnt(0)" ::: "memory");
        __syncthreads();
        if (laus(my_wave(lds)) == 0 && lauv(my_lane()) == 0) { __builtin_amdgcn_fence(__ATOMIC_RELEASE, "agent"); asm volatile("s_waitcnt vmcnt(0)" ::: "memory");
            (void)__hip_atomic_fetch_add(flags + 64 * w, 1u, __ATOMIC_RELAXED, __HIP_MEMORY_SCOPE_AGENT); }
    }
}

__device__ __forceinline__ void gdn_sso_phase(KP P, LAS unsigned char* lds) {
    P = lau(P);
    const int lane = lauv(my_lane()), wave = laus(my_wave(lds)), ngw = gridDim.x * NWAVES, gw = blockIdx.x * NWAVES + wave;
    unsigned char* ws = lau(P->ws); const bf16_t* o = (const bf16_t*)(ws + WS_RB) + 2048; float* sso = (float*)(ws + WS_SSO);
    for (int r = gw; r < T; r += ngw) {
        float s = 0.f;
#pragma unroll
        for (int j = 0; j < 8; ++j) { const f32x4 v = ld_bf4(o + (size_t)r * 4096 + 32 * lane + 4 * j); s += (v[0] * v[0] + v[1] * v[1]) + (v[2] * v[2] + v[3] * v[3]); }
        s += dpp_f<0xB1>(s); s += dpp_f<0x4E>(s);
        if ((lane & 3) == 0) sso[r * 16 + (lane >> 2)] = s;
    }
}
__device__ __forceinline__ void ssh2_reduce_phase(KP P, LAS unsigned char* lds) {
    P = lau(P);
    const int lane = lauv(my_lane()), wave = laus(my_wave(lds));
    unsigned char* ws = lau(P->ws); const float* part = (const float*)(ws + WS_SSH2P); float* ssh2 = (float*)(ws + WS_SSH2);
    const int r = (blockIdx.x * NWAVES + wave) * 64 + lane;
    if (r < T) { f32x4 a = *(const f32x4*)(part + (size_t)r * 16), b = *(const f32x4*)(part + (size_t)r * 16 + 4), c = *(const f32x4*)(part + (size_t)r * 16 + 8), d = *(const f32x4*)(part + (size_t)r * 16 + 12);
        a = (a + b) + (c + d); ssh2[r] = (a[0] + a[1]) + (a[2] + a[3]); }
}


__device__ __forceinline__ void nsa_item(KP P, int g, int tb, LAS unsigned char* wl, int lane) {
    const int fr = lane & 15, fq = lane >> 4, t0 = tb * 16, tq = t0 + fr;
    unsigned char* ws = lau(lau(P)->ws);
    const bf16_t* qb = (const bf16_t*)(ws + WS_RA);
    bf16_t* ob = (bf16_t*)(ws + WS_RA + 64 * MiB);
    const bf16_t* kbuf = (const bf16_t*)(ws + WS_RB + RB_KBUF);
    const bf16_t* kslc = kbuf + ((size_t)(2 * 4 + g) * T) * 64; const bf16_t* kwin = kbuf + ((size_t)(3 * 4 + g) * T) * 64;
    const bf16_t* vT = (const bf16_t*)(ws + WS_RA + RA_VT);
    const bf16_t* vslcT = vT + (size_t)g * T * 64; const bf16_t* vwinT = vT + (size_t)(1 * 256 + g * 64) * VT_LD;
    const bf16_t* kc = (const bf16_t*)(ws + WS_RB + RB_KC) + (size_t)g * 1024 * 256;
    const bf16_t* vcT = (const bf16_t*)(ws + WS_RB + RB_VCT) + (size_t)g * 256 * 1024;
    LAS float* imp = (LAS float*)wl;
    LAS int* sel = (LAS int*)(wl + 16448);
    const int krow = 8 * (fr >> 2) + (fr & 3);
    const float zf = __builtin_bit_cast(float, lauv(0));
    const f32x4 z4 = (f32x4){zf, zf, zf, zf};

    for (int x = lane; x < 16 * 257; x += 64) imp[x] = 0.f;
    bf16x8 Q[4][2];
#pragma unroll
    for (int r = 0; r < 4; ++r)
#pragma unroll
        for (int kk = 0; kk < 2; ++kk) Q[r][kk] = ldg16(qb + (size_t)tq * 1280 + (g * 4 + r) * 64 + kk * 32 + fq * 8);

    const int nst = (tb + 31) >> 5;
    float mf[4], inv[4];
    {
        float m1[4], l1[4];
#pragma unroll
        for (int r = 0; r < 4; ++r) { m1[r] = -1e30f; l1[r] = 0.f; }
        for (int st = 0; st < nst; ++st) {
            bf16x8 K[2][2];
#pragma unroll
            for (int e = 0; e < 2; ++e)
#pragma unroll
                for (int kk = 0; kk < 2; ++kk) K[e][kk] = ldg16(kc + (size_t)(32 * st + krow + 4 * e) * 256 + kk * 32 + fq * 8);
#pragma unroll
            for (int r = 0; r < 4; ++r) {
                f32x4 s[2]; float mt = -1e30f;
#pragma unroll
                for (int e = 0; e < 2; ++e) { s[e] = MFMA16(K[e][0], Q[r][0], z4); s[e] = MFMA16(K[e][1], Q[r][1], s[e]);
#pragma unroll
                    for (int jj = 0; jj < 4; ++jj) { const int key = 32 * st + 8 * fq + 4 * e + jj; const bool vis = (16 * key + 31 <= tq); s[e][jj] = vis ? s[e][jj] : -1e30f; mt = fmaxf(mt, s[e][jj]); } }
                const float mn = fmaxf(m1[r], mt); float ls = 0.f;
#pragma unroll
                for (int e = 0; e < 2; ++e)
#pragma unroll
                    for (int jj = 0; jj < 4; ++jj) ls += (s[e][jj] > -1e29f) ? __expf(s[e][jj] - mn) : 0.f;
                l1[r] = l1[r] * __expf(m1[r] - mn) + ls; m1[r] = mn;
            }
        }
#pragma unroll
        for (int r = 0; r < 4; ++r) { float M = m1[r]; M = fmaxf(M, shx(M, 16, lane)); M = fmaxf(M, shx(M, 32, lane));
            float L = l1[r] * __expf(m1[r] - M); L += shx(L, 16, lane); L += shx(L, 32, lane);
            mf[r] = M; inv[r] = L > 0.f ? 1.f / L : 0.f; }
    }
    {
        f32x4 oc[4][4];
#pragma unroll
        for (int r = 0; r < 4; ++r)
#pragma unroll
            for (int dt = 0; dt < 4; ++dt) oc[r][dt] = z4;
        for (int st = 0; st < nst; ++st) {
            bf16x8 K[2][2], V[4];
#pragma unroll
            for (int e = 0; e < 2; ++e)
#pragma unroll
                for (int kk = 0; kk < 2; ++kk) K[e][kk] = ldg16(kc + (size_t)(32 * st + krow + 4 * e) * 256 + kk * 32 + fq * 8);
#pragma unroll
            for (int dt = 0; dt < 4; ++dt) V[dt] = ldg16(vcT + (size_t)(16 * dt + fr) * 1024 + 32 * st + 8 * fq);
            f32x4 ps[2]; ps[0] = z4; ps[1] = z4;
#pragma unroll
            for (int r = 0; r < 4; ++r) {
                f32x4 s[2];
#pragma unroll
                for (int e = 0; e < 2; ++e) { s[e] = MFMA16(K[e][0], Q[r][0], z4); s[e] = MFMA16(K[e][1], Q[r][1], s[e]);
#pragma unroll
                    for (int jj = 0; jj < 4; ++jj) { const int key = 32 * st + 8 * fq + 4 * e + jj; const bool vis = (16 * key + 31 <= tq); s[e][jj] = vis ? __expf(s[e][jj] - mf[r]) * inv[r] : 0.f; }
                    ps[e] += s[e]; }
                const bf16x8 Pm = pack8(s[0], s[1]);
#pragma unroll
                for (int dt = 0; dt < 4; ++dt) oc[r][dt] = MFMA16(V[dt], Pm, oc[r][dt]);
            }
            const int k0 = 8 * st + 2 * fq;
            const float a = 2.f * (ps[0][0] + ps[0][1] + ps[0][2]) + ps[0][3], b = ps[0][3] + 2.f * (ps[1][0] + ps[1][1] + ps[1][2]) + ps[1][3], c = ps[1][3];
            LAS float* ip = imp + fr * 257 + k0;
            ip[0] += a; ip[1] += b;
            asm volatile("" ::: "memory");
            if (k0 + 2 < 256) ip[2] += c;
            asm volatile("" ::: "memory");
        }
        asm volatile("s_waitcnt lgkmcnt(0)" ::: "memory");
        for (int i = 0; i < 16; ++i) {
            const int t = t0 + i, cur = t >> 6;
            unsigned key[4];
#pragma unroll
            for (int c = 0; c < 4; ++c) { const int k = lane + 64 * c; const float v = imp[i * 257 + k]; const bool valid = k <= cur, forced = (k == 0) || (k == cur) || (k == cur - 1);
                const unsigned bits = forced ? __float_as_uint(1e4f) : __float_as_uint(v); key[c] = valid ? ((bits & 0xFFFFFF00u) | (unsigned)(255 - k)) : 0u; }
            for (int n = 0; n < 16; ++n) {
                unsigned mx = umax_(umax_(key[0], key[1]), umax_(key[2], key[3]));
                mx = wave_max_u32(mx);
                if (lane == 0) sel[i * 16 + n] = mx ? (int)(255u - (mx & 255u)) : -1;
#pragma unroll
                for (int c = 0; c < 4; ++c) key[c] = (key[c] == mx) ? 0u : key[c];
            }
        }
        asm volatile("s_waitcnt lgkmcnt(0)" ::: "memory");
#pragma unroll
        for (int r = 0; r < 4; ++r) { const float g0 = sigmoidf_(bf2f(qb[(size_t)tq * 1280 + 1024 + (g * 4 + r) * 3 + 0]));
#pragma unroll
            for (int dt = 0; dt < 4; ++dt) *(LAS f32x4*)(imp + (fr * 4 + r) * 64 + 16 * dt + 4 * fq) = oc[r][dt] * g0; }
    }
    {
        f32x4 ow[4][4]; float mw[4], lw[4];
#pragma unroll
        for (int r = 0; r < 4; ++r) { mw[r] = -1e30f; lw[r] = 0.f;
#pragma unroll
            for (int dt = 0; dt < 4; ++dt) ow[r][dt] = z4; }
        const int lo = t0 - 511 > 0 ? t0 - 511 : 0, st_lo = lo >> 5, st_hi = (t0 + 15) >> 5;
        for (int st = st_lo; st <= st_hi; ++st) {
            bf16x8 K[2][2], V[4];
#pragma unroll
            for (int e = 0; e < 2; ++e)
#pragma unroll
                for (int kk = 0; kk < 2; ++kk) K[e][kk] = ldg16(kwin + (size_t)(32 * st + krow + 4 * e) * 64 + kk * 32 + fq * 8);
#pragma unroll
            for (int dt = 0; dt < 4; ++dt) V[dt] = ldg16(vwinT + (size_t)(16 * dt + fr) * VT_LD + 32 * st + 8 * fq);
#pragma unroll
            for (int r = 0; r < 4; ++r) {
                f32x4 s[2]; float mt = -1e30f;
#pragma unroll
                for (int e = 0; e < 2; ++e) { s[e] = MFMA16(K[e][0], Q[r][0], z4); s[e] = MFMA16(K[e][1], Q[r][1], s[e]);
#pragma unroll
                    for (int jj = 0; jj < 4; ++jj) { const int pos = 32 * st + 8 * fq + 4 * e + jj; const bool vis = (pos <= tq) && (pos > tq - 512); s[e][jj] = vis ? s[e][jj] : -1e30f; mt = fmaxf(mt, s[e][jj]); } }
                mt = fmaxf(mt, shx(mt, 16, lane)); mt = fmaxf(mt, shx(mt, 32, lane));
                const float mn = fmaxf(mw[r], mt), al = __expf(mw[r] - mn); mw[r] = mn; float ls = 0.f;
#pragma unroll
                for (int e = 0; e < 2; ++e)
#pragma unroll
                    for (int jj = 0; jj < 4; ++jj) { s[e][jj] = (s[e][jj] > -1e29f) ? __expf(s[e][jj] - mn) : 0.f; ls += s[e][jj]; }
                lw[r] = lw[r] * al + ls;
                const bf16x8 Pm = pack8(s[0], s[1]);
#pragma unroll
                for (int dt = 0; dt < 4; ++dt) { ow[r][dt] = ow[r][dt] * al; ow[r][dt] = MFMA16(V[dt], Pm, ow[r][dt]); }
            }
        }
#pragma unroll
        for (int r = 0; r < 4; ++r) { float L = lw[r]; L += shx(L, 16, lane); L += shx(L, 32, lane);
            const float sc = sigmoidf_(bf2f(qb[(size_t)tq * 1280 + 1024 + (g * 4 + r) * 3 + 2])) / L;
#pragma unroll
            for (int dt = 0; dt < 4; ++dt) { LAS f32x4* cp = (LAS f32x4*)(imp + (fr * 4 + r) * 64 + 16 * dt + 4 * fq); *cp = *cp + ow[r][dt] * sc; } }
    }
    asm volatile("s_waitcnt lgkmcnt(0)" ::: "memory");
    for (int i = 0; i < 16; ++i) {
        const int t = t0 + i;
        bf16x8 Qs[2];
#pragma unroll
        for (int kk = 0; kk < 2; ++kk) { Qs[kk] = ldg16(qb + (size_t)t * 1280 + (g * 4 + (fr & 3)) * 64 + kk * 32 + fq * 8); if (fr >= 4) Qs[kk] = (bf16x8){0, 0, 0, 0, 0, 0, 0, 0}; }
        f32x4 os[4]; float ms = -1e30f, lsum = 0.f;
#pragma unroll
        for (int dt = 0; dt < 4; ++dt) os[dt] = z4;
        int nv = 0;
        for (int n = 0; n < 16; ++n) nv += (__builtin_amdgcn_readfirstlane(sel[i * 16 + n]) >= 0) ? 1 : 0;
#define SEL_LOAD(K_, V_, kb_) do { _Pragma("unroll") for (int e = 0; e < 2; ++e) _Pragma("unroll") for (int kk = 0; kk < 2; ++kk) K_[e][kk] = ldg16(kslc + (size_t)((kb_) >> 5) * 2048 + ((e * 2 + kk) * 64 + lane) * 8); \
        _Pragma("unroll") for (int dt = 0; dt < 4; ++dt) V_[dt] = ldg16(vslcT + (size_t)((kb_) >> 5) * 2048 + (dt * 64 + lane) * 8); } while (0)
#define SEL_COMP(K_, V_, kb_, FULL_) do { f32x4 s[2]; float mt = -1e30f; \
        _Pragma("unroll") for (int e = 0; e < 2; ++e) { s[e] = MFMA16(K_[e][0], Qs[0], z4); s[e] = MFMA16(K_[e][1], Qs[1], s[e]); \
            _Pragma("unroll") for (int jj = 0; jj < 4; ++jj) { const int pos = (kb_) + 8 * fq + 4 * e + jj; const float sv = s[e][jj] * 1.44269504f;     \
                s[e][jj] = (FULL_ || pos <= t) ? sv : -1e30f; mt = fmaxf(mt, s[e][jj]); } } \
        mt = fmaxf(mt, shx(mt, 16, lane)); mt = fmaxf(mt, shx(mt, 32, lane)); \
        const float mn = fmaxf(ms, mt); float ls = 0.f; \
        if (__builtin_amdgcn_ballot_w64(mn > ms) != 0ull) {     \
            const float al = __builtin_amdgcn_exp2f(ms - mn); lsum *= al; _Pragma("unroll") for (int dt = 0; dt < 4; ++dt) os[dt] = os[dt] * al; } \
        ms = mn; \
        _Pragma("unroll") for (int e = 0; e < 2; ++e) _Pragma("unroll") for (int jj = 0; jj < 4; ++jj) { const float pv = __builtin_amdgcn_exp2f(s[e][jj] - mn); s[e][jj] = (FULL_ || s[e][jj] > -1e29f) ? pv : 0.f; ls += s[e][jj]; } \
        lsum += ls; \
        const bf16x8 Pm = pack8(s[0], s[1]); \
        _Pragma("unroll") for (int dt = 0; dt < 4; ++dt) os[dt] = MFMA16(V_[dt], Pm, os[dt]); } while (0)
        bf16x8 KA[2][2], VA[4], KB[2][2], VB[4];
        for (int n = 0; n < nv; ++n) {
            const int b = __builtin_amdgcn_readfirstlane(sel[i * 16 + n]);
            SEL_LOAD(KA, VA, b * 64); SEL_LOAD(KB, VB, b * 64 + 32);
            if (b < (t >> 6)) { SEL_COMP(KA, VA, b * 64, true); SEL_COMP(KB, VB, b * 64 + 32, true); }
            else { SEL_COMP(KA, VA, b * 64, false); SEL_COMP(KB, VB, b * 64 + 32, false); }
        }
#undef SEL_LOAD
#undef SEL_COMP
        float L = lsum; L += shx(L, 16, lane); L += shx(L, 32, lane);
        if (fr < 4) {
            const float sc = sigmoidf_(bf2f(qb[(size_t)t * 1280 + 1024 + (g * 4 + fr) * 3 + 1])) / L;
#pragma unroll
            for (int dt = 0; dt < 4; ++dt) { const f32x4 cb = *(const LAS f32x4*)(imp + (i * 4 + fr) * 64 + 16 * dt + 4 * fq);
                st_bf4(ob + (size_t)t * 1024 + (g * 4 + fr) * 64 + 16 * dt + 4 * fq, cb + os[dt] * sc); }
        }
    }
    asm volatile("s_waitcnt lgkmcnt(0)" ::: "memory");
}
__device__ __forceinline__ void nsa_attn_phase(KP P, LAS unsigned char* lds) {
    P = lau(P);
    const int lane = lauv(my_lane()), wave = laus(my_wave(lds)), ngw = gridDim.x * NWAVES, gw = blockIdx.x * NWAVES + wave;
    LAS unsigned char* wl = lds + wave * NSA_WAVE_LDS;
    for (int it = gw; it < 2048; it += ngw) {
        int g = it & 3, tb = it >> 2;
        if (gridDim.x == 256) { const int bxx = blockIdx.x; g = (bxx & 7) >> 1; tb = (((bxx >> 3) * 2 + (bxx & 1)) * NWAVES) + wave; }
        for (int half = 0; half < 2; ++half) nsa_item(P, g, half ? 1023 - tb : tb, wl, lane);
    }
}

__global__ void __launch_bounds__(NTHREADS, 2) fwd_megakernel(Params P_arg) {
    KP P = (KP)__builtin_amdgcn_kernarg_segment_ptr();
    extern __shared__ __attribute__((aligned(16))) unsigned char lds_raw[];
    LAS unsigned char* lds = (LAS unsigned char*)lds_raw;
    { const int tid0 = threadIdx.x; if ((tid0 & 63) == 0) ((LAS int*)(lds + LDS_TBL))[hw_slot()] = tid0 >> 6;
      if (tid0 < 2) ((LAS unsigned*)(lds + LDS_XB))[tid0] = 0u;
      if (tid0 == 0) (void)xb_add((unsigned*)(lau(lau(P)->ws) + WS_XBAR) + XB_XCNT(xb_xcc_id()), 1u); }
    __syncthreads();
#define G ((int)gridDim.x)
#define bx ((int)blockIdx.x)
    using pg8::Gemm; using pg8::StaticOrder; using pg8::gemm_phase; using pg8::EpiFn; using pg8::EpiSS;
#define RUN_GEMM(gm, Mm, Nn, cc, epi) do { StaticOrder S_; S_.init((Mm), (Nn), laus((int)gridDim.x), laus((int)(cc))); gemm_phase(lds, (gm), S_, (epi)); } while (0)
#define HB_CUR(ws_, li_) ((bf16_t*)((ws_) + (((li_) & 1) ? WS_HBB : WS_HBA)))
#define HB_NXT(ws_, li_) ((bf16_t*)((ws_) + (((li_) & 1) ? WS_HBA : WS_HBB)))

    rows_phase(P, 0, 0, (bf16_t*)(lau(lau(P)->ws) + WS_HBA), nullptr, nullptr, lds);
    convert_layer(P, 0, lds);
    GRID_SYNC();
    if (laus(my_wave(lds)) == 0 && lauv(my_lane()) == 0) { unsigned nloc, nx; xcd_barrier_complete((unsigned*)(lau(lau(P)->ws) + WS_XBAR), xb_xcc_id(), nloc, nx); ((LAS unsigned*)(lds + LDS_XB))[0] = nloc; ((LAS unsigned*)(lds + LDS_XB))[1] = nx; }
    __syncthreads();

    for (int li = 0; li < 4; ++li) {
        if (li > 0) { ssh2_reduce_phase(P, lds); convert_layer(P, li, lds); if (li == 2) cmp_bias(P, lds); xcd_grid_barrier(P, lds); }
        if (li < 2) {
            { unsigned char* ws = lau(lau(P)->ws); const float* ssh2 = (const float*)(ws + WS_SSH2); float* bg = (float*)(ws + WS_BG); bf16_t* RA = (bf16_t*)(ws + WS_RA);
              Gemm gm{HB_CUR(ws, li), (const bf16_t*)(ws + WS_W + W_WIN), T, 4352, D, D, D};
              auto E_l = [=](int row, int cb, const f32x4& v0, const f32x4& v1) { const float rs = rsqrtf(ssh2[row] * (1.f / D) + EPS);
                  if (cb < 4096) { st_bf4(RA + (size_t)row * 4096 + cb, v0 * rs); st_bf4(RA + (size_t)row * 4096 + cb + 16, v1 * rs); }
                  else if (cb < 4128) { const int c = cb - 4096; if (c < 16) { *(f32x4*)(bg + (size_t)row * 32 + c) = v0 * rs; *(f32x4*)(bg + (size_t)row * 32 + c + 16) = v1 * rs; } } };
              EpiFn<decltype(E_l)> E{E_l};
              RUN_GEMM(gm, T, 4352, bx, E); }
            xcd_grid_barrier(P, lds);
            gdn_conv_phase(P, li, lds);
            xcd_grid_barrier(P, lds);
#ifdef GDN_NAIVE
            gdn_scan_phase(P, lds);
            xcd_grid_barrier(P, lds);
#else
            gdn_prep_pipe(P, li, lds);
            gdn_scan2_phase(P, li, lds);
            xcd_grid_barrier(P, lds);
#endif
            gdn_sso_phase(P, lds);
            xcd_grid_barrier(P, lds);
            { unsigned char* ws = lau(lau(P)->ws); const float* ssh2 = (const float*)(ws + WS_SSH2); const float* sso = (const float*)(ws + WS_SSO); bf16_t* RB = (bf16_t*)(ws + WS_RB);
              Gemm gm{HB_CUR(ws, li), (const bf16_t*)(ws + WS_W + W_WZ), T, 2048, D, D, D};
              const float* onorm = lau(lau(P)->gdn_o_norm) + li * 128;
              auto E_l = [=](int row, int cb, const f32x4& v0, const f32x4& v1) { const float rs = rsqrtf(ssh2[row] * (1.f / D) + EPS);
                  const float rr = rsqrtf(sso[row * 16 + (cb >> 7)] * (1.f / 128.f) + EPS);
                  bf16_t* op = RB + (size_t)row * 4096 + 2048 + cb;
#pragma unroll
                  for (int h = 0; h < 2; ++h) { const f32x4 z = (h ? v1 : v0) * rs; const f32x4 o = ld_bf4(op + 16 * h); const f32x4 gn = *(const f32x4*)(onorm + ((cb + 16 * h) & 127)); f32x4 r;
#pragma unroll
                      for (int e = 0; e < 4; ++e) r[e] = o[e] * rr * gn[e] * siluf_(z[e]);
                      st_bf4(op + 16 * h, r); } };
              EpiFn<decltype(E_l)> E{E_l};
              RUN_GEMM(gm, T, 2048, bx, E); }
            xcd_grid_barrier(P, lds);
            { unsigned char* ws = lau(lau(P)->ws);
              Gemm gm{(const bf16_t*)(ws + WS_RB) + 2048, (const bf16_t*)(ws + WS_W + W_WOUT), T, D, 2048, 4096, 2048};
              auto gl = [=](int, int, f32x4&, f32x4&) {}; EpiSS<decltype(gl)> E{gl, (float*)(ws + WS_RA), (float*)(ws + WS_SSYP), D};
              RUN_GEMM(gm, T, D, bx, E); }
            xcd_grid_barrier(P, lds);
        } else {
            { unsigned char* ws = lau(lau(P)->ws); const float* ssh2 = (const float*)(ws + WS_SSH2); bf16_t* RA = (bf16_t*)(ws + WS_RA);
              Gemm gm{HB_CUR(ws, li), (const bf16_t*)(ws + WS_W + W_WQ), T, 1280, D, D, D};
              auto E_l = [=](int row, int cb, const f32x4& v0, const f32x4& v1) { const float rs = rsqrtf(ssh2[row] * (1.f / D) + EPS);
                  st_bf4(RA + (size_t)row * 1280 + cb, v0 * rs); st_bf4(RA + (size_t)row * 1280 + cb + 16, v1 * rs); };
              EpiFn<decltype(E_l)> E{E_l};
              RUN_GEMM(gm, T, 1280, bx, E); }
            if (li == 2) {
                { unsigned char* ws = lau(lau(P)->ws); const float* ssh2 = (const float*)(ws + WS_SSH2); bf16_t* kbuf = (bf16_t*)(ws + WS_RB + RB_KBUF);
                  Gemm gm{HB_CUR(ws, li), (const bf16_t*)(ws + WS_W + W_WK), T, 1024, D, D, D};
                  auto E_l = [=](int row, int cb, const f32x4& v0, const f32x4& v1) { const float rs = rsqrtf(ssh2[row] * (1.f / D) + EPS);
                      const int gi = cb >> 6, d0 = cb & 63;
                      if ((gi >> 2) == 2) {
                          const int k5 = row & 31, fr_ = ((k5 >> 3) << 2) | (k5 & 3), e_ = (k5 >> 2) & 1;
                          bf16_t* hb = kbuf + (size_t)gi * T * 64 + (size_t)(row >> 5) * 2048;
                          const int d1 = d0 + 16;
                          st_bf4(hb + ((e_ * 2 + (d0 >> 5)) * 64 + ((d0 >> 3) & 3) * 16 + fr_) * 8 + (d0 & 4), v0 * rs);
                          st_bf4(hb + ((e_ * 2 + (d1 >> 5)) * 64 + ((d1 >> 3) & 3) * 16 + fr_) * 8 + (d1 & 4), v1 * rs);
                      } else { bf16_t* dp = kbuf + ((size_t)gi * T + row) * 64 + d0; st_bf4(dp, v0 * rs); st_bf4(dp + 16, v1 * rs); } };
                  EpiFn<decltype(E_l)> E{E_l};
                  RUN_GEMM(gm, T, 1024, (bx + 64) % G, E); }
                { unsigned char* ws = lau(lau(P)->ws); const float* ssh2 = (const float*)(ws + WS_SSH2); bf16_t* vT = (bf16_t*)(ws + WS_RA + RA_VT);
                  Gemm gm{(const bf16_t*)(ws + WS_W + W_WV), HB_CUR(ws, li), 512, T, D, D, D};
                  auto E_l = [=](int row, int cb, const f32x4& v0, const f32x4& v1) {
#pragma unroll
                      for (int h = 0; h < 2; ++h) { const int c = cb + 16 * h; const f32x4 ss4 = *(const f32x4*)(ssh2 + c); f32x4 v = h ? v1 : v0;
#pragma unroll
                          for (int e = 0; e < 4; ++e) v[e] *= rsqrtf(ss4[e] * (1.f / D) + EPS);
                          if (row < 256) {
                              const int g_ = row >> 6, d_ = row & 63;
                              st_bf4(vT + (size_t)g_ * T * 64 + (size_t)(c >> 5) * 2048 + ((d_ >> 4) * 64 + ((c & 31) >> 3) * 16 + (d_ & 15)) * 8 + (c & 4), v);
                          } else st_bf4(vT + (size_t)row * VT_LD + c, v); } };
                  EpiFn<decltype(E_l)> E{E_l};
                  RUN_GEMM(gm, 512, T, (bx + 128) % G, E); }
                xcd_grid_barrier(P, lds);
                for (int idx = 0; idx < 2; ++idx) {
                    unsigned char* ws = lau(lau(P)->ws);
                    Gemm gm{(const bf16_t*)(ws + WS_RB + RB_KBUF) + (size_t)idx * 4 * T * 64, (const bf16_t*)(ws + WS_W + W_W1T) + (size_t)idx * 256 * 2048, 4096, 256, 2048, 1024, 2048};
                    bf16_t* hd = (bf16_t*)(ws + WS_RB + RB_HID) + (size_t)idx * 4096 * 256; const float* b1 = (const float*)(ws + WS_BIAS1) + idx * 256;
                    auto E_l = [=](int row, int cb, const f32x4& v0, const f32x4& v1) {
#pragma unroll
                        for (int h = 0; h < 2; ++h) { const int c = cb + 16 * h; f32x4 v = (h ? v1 : v0) + *(const f32x4*)(b1 + c);
#pragma unroll
                            for (int e = 0; e < 4; ++e) v[e] = siluf_(v[e]);
                            st_bf4(hd + (size_t)row * 256 + c, v); } };
                    EpiFn<decltype(E_l)> E{E_l};
                    RUN_GEMM(gm, 4096, 256, (bx + 128 * idx) % G, E);
                }
                xcd_grid_barrier(P, lds);
                { unsigned char* ws = lau(lau(P)->ws); bf16_t* kcb = (bf16_t*)(ws + WS_RB + RB_KC);
                  Gemm gm{(const bf16_t*)(ws + WS_RB + RB_HID), (const bf16_t*)(ws + WS_W + W_W2T), 4096, 256, 256, 256, 256};
                  auto E_l = [=](int row, int cb, const f32x4& v0, const f32x4& v1) { const float zz = ((row & 1023) == 1023) ? 0.f : 1.f; st_bf4(kcb + (size_t)row * 256 + cb, v0 * zz); st_bf4(kcb + (size_t)row * 256 + cb + 16, v1 * zz); };
                  EpiFn<decltype(E_l)> E{E_l};
                  RUN_GEMM(gm, 4096, 256, bx, E); }
                { unsigned char* ws = lau(lau(P)->ws); bf16_t* vct = (bf16_t*)(ws + WS_RB + RB_VCT);
                  Gemm gm{(const bf16_t*)(ws + WS_W + W_W2T) + (size_t)256 * 256, (const bf16_t*)(ws + WS_RB + RB_HID) + (size_t)4096 * 256, 256, 4096, 256, 256, 256};
                  auto E_l = [=](int row, int cb, const f32x4& v0, const f32x4& v1) {
#pragma unroll
                      for (int h = 0; h < 2; ++h) { const int c = cb + 16 * h; f32x4 v = h ? v1 : v0; v[3] = ((c & 1023) == 1020) ? 0.f : v[3];
                          st_bf4(vct + ((size_t)((c >> 10) * 256 + row)) * 1024 + (c & 1023), v); } };
                  EpiFn<decltype(E_l)> E{E_l};
                  RUN_GEMM(gm, 256, 4096, (bx + 128) % G, E); }
            }
            xcd_grid_barrier(P, lds);
#ifdef DBG_SKIP_NSA
            { unsigned char* ws = lau(lau(P)->ws); const int lane = lauv(my_lane()), wave = laus(my_wave(lds)); const bf16_t* qb = (const bf16_t*)(ws + WS_RA); bf16_t* ob = (bf16_t*)(ws + WS_RA + 64 * MiB);
              for (int r = bx * NWAVES + wave; r < T; r += G * NWAVES) for (int j = 0; j < 4; ++j) *(u32x2*)(ob + (size_t)r * 1024 + 4 * lane + 256 * j) = *(const u32x2*)(qb + (size_t)r * 1280 + 4 * lane + 256 * j); }
#else
            nsa_attn_phase(P, lds);
#endif
            xcd_grid_barrier(P, lds);
            { unsigned char* ws = lau(lau(P)->ws);
              Gemm gm{(const bf16_t*)(ws + WS_RA + 64 * MiB), (const bf16_t*)(ws + WS_W + W_WO), T, D, D, D, D};
              auto gl = [=](int, int, f32x4&, f32x4&) {}; EpiSS<decltype(gl)> E{gl, (float*)(ws + WS_RB + RB_Y), (float*)(ws + WS_SSYP), D};
              RUN_GEMM(gm, T, D, bx, E); }
            xcd_grid_barrier(P, lds);
        }
        { unsigned char* ws = lau(lau(P)->ws);
          rows_phase(P, 1, li, HB_CUR(ws, li), lau(lau(P)->mix_post) + li * D, (li < 2) ? (const float*)(ws + WS_RA) : (const float*)(ws + WS_RB + RB_Y), lds); }
        xcd_grid_barrier(P, lds);
        { unsigned char* ws = lau(lau(P)->ws); const float* ssh1 = (const float*)(ws + WS_SSH1); bf16_t* RA = (bf16_t*)(ws + WS_RA);
          Gemm gm{HB_CUR(ws, li), (const bf16_t*)(ws + WS_W + W_FFNIN), T, 2 * FF, D, D, D};
          auto E_l = [=](int row, int cb, const f32x4& v0, const f32x4& v1) { const float rs = rsqrtf(ssh1[row] * (1.f / D) + EPS);
              const int pn = cb >> 8, r = cb & 255, hidc = 128 * pn + 64 * (r >> 7) + 16 * ((r & 127) >> 5) + (r & 15);
              f32x4 o;
#pragma unroll
              for (int e = 0; e < 4; ++e) o[e] = siluf_(v0[e] * rs) * (v1[e] * rs);
              st_bf4(RA + (size_t)row * FF + hidc, o); };
          EpiFn<decltype(E_l)> E{E_l};
          RUN_GEMM(gm, T, 2 * FF, bx, E); }
        xcd_grid_barrier(P, lds);
        { unsigned char* ws = lau(lau(P)->ws);
          Gemm gm{(const bf16_t*)(ws + WS_RA), (const bf16_t*)(ws + WS_W + W_FFNOUT), T, D, FF, FF, FF};
          auto gl = [=](int, int, f32x4&, f32x4&) {}; EpiSS<decltype(gl)> E{gl, (float*)(ws + WS_RB + RB_Y), (float*)(ws + WS_SSYP), D};
          RUN_GEMM(gm, T, D, bx, E); }
        xcd_grid_barrier(P, lds);
        { unsigned char* ws = lau(lau(P)->ws);
          rows_phase(P, 2, li, HB_CUR(ws, li), lau(lau(P)->ffn_post) + li * D, (const float*)(ws + WS_RB + RB_Y), lds); }
        xcd_grid_barrier(P, lds);
        { unsigned char* ws = lau(lau(P)->ws); float* t1 = (float*)(ws + WS_RA);
          Gemm gm{(const bf16_t*)(ws + WS_RB + RB_PB), (const bf16_t*)(ws + WS_W + W_PLE), T, D, PLE, PLE, PLE};
          auto E_l = [=](int row, int cb, const f32x4& v0, const f32x4& v1) { *(f32x4*)(t1 + (size_t)row * D + cb) = v0; *(f32x4*)(t1 + (size_t)row * D + cb + 16) = v1; };
          EpiFn<decltype(E_l)> E{E_l};
          RUN_GEMM(gm, T, D, bx, E); }
        asm volatile("s_waitcnt vmcnt(0)" ::: "memory");
        { unsigned char* ws = lau(lau(P)->ws); const float* t1 = (const float*)(ws + WS_RA); bf16_t* hbn = HB_NXT(ws, li);
          Gemm gm{HB_CUR(ws, li), (const bf16_t*)(ws + WS_W + W_GATE), T, D, D, D, D};
          float* hout = lau(lau(P)->out);
          auto gl = [=](int row, int cb, f32x4& o0, f32x4& o1) {
#pragma unroll
              for (int h = 0; h < 2; ++h) { const int c = cb + 16 * h; f32x4& o = h ? o1 : o0; const f32x4 tt = *(const f32x4*)(t1 + (size_t)row * D + c), h0 = *(const f32x4*)(hout + (size_t)row * D + c);
#pragma unroll
                  for (int e = 0; e < 4; ++e) o[e] = h0[e] + tt[e] * sigmoidf_(o[e]);
                  st_bf4(hbn + (size_t)row * D + c, o); } };
          EpiSS<decltype(gl)> E{gl, hout, (float*)(ws + WS_SSH2P), D};
          RUN_GEMM(gm, T, D, bx, E); }
        xcd_grid_barrier(P, lds);
    }
}

extern "C" void kernel_launch(void* const* d_in, const int* in_sizes, int n_in, void* d_out, int out_size, void* d_ws, size_t ws_size, hipStream_t stream) {
    static int grid = 0;
    if (grid == 0) {
        if (n_in != 23 || out_size != T * D || ws_size < WS_END) { fprintf(stderr, "kernel_launch: unexpected problem (n_in %d out %d ws %zu, need %zu)\n", n_in, out_size, ws_size, (size_t)WS_END); grid = -1; return; }
        int dev = 0, cus = 0, per_cu = 0;
        (void)hipGetDevice(&dev); (void)hipDeviceGetAttribute(&cus, hipDeviceAttributeMultiprocessorCount, dev);
        (void)hipFuncSetAttribute((const void*)fwd_megakernel, hipFuncAttributeMaxDynamicSharedMemorySize, LDS_BYTES);
        (void)hipOccupancyMaxActiveBlocksPerMultiprocessor(&per_cu, (const void*)fwd_megakernel, NTHREADS, LDS_BYTES);
        if (per_cu < 1) per_cu = 1;
        grid = cus;
        (void)hipGetLastError();
        fprintf(stderr, "kernel_launch: grid %d (cus %d, per_cu %d), ws %zu\n", grid, cus, per_cu, ws_size);
    }
    if (grid < 0) return;
    Params prm{};
    const float** pp = (const float**)&prm;
    for (int i = 0; i < 23; ++i) pp[i] = (const float*)d_in[i];
    prm.out = (float*)d_out; prm.ws = (unsigned char*)d_ws;
    (void)hipMemsetAsync((unsigned char*)d_ws + WS_XBAR, 0, 32768, stream);
    void* args[] = {&prm};
    hipError_t e = hipLaunchCooperativeKernel((const void*)fwd_megakernel, dim3(grid), dim3(NTHREADS), args, LDS_BYTES, stream);
    if (e != hipSuccess) fprintf(stderr, "cooperative launch failed: %s (grid %d)\n", hipGetErrorString(e), grid);
}
```

```cpp
#include <hip/hip_runtime.h>
#include <hip/hip_cooperative_groups.h>
#include <cstdio>
#include <cstdint>
namespace cg = cooperative_groups;
#define GRID_SYNC() do { asm volatile("s_waitcnt vmcnt(0) lgkmcnt(0)" ::: "memory"); cg::this_grid().sync(); } while (0)

#define LAS __attribute__((address_space(3)))
typedef unsigned short bf16_t;
typedef short bf16x8 __attribute__((ext_vector_type(8)));
typedef float f32x4 __attribute__((ext_vector_type(4)));
typedef float f32x2 __attribute__((ext_vector_type(2)));
typedef unsigned u32x4 __attribute__((ext_vector_type(4)));
typedef unsigned u32x2 __attribute__((ext_vector_type(2)));

constexpr int T = 16384, D = 1024, PLE = 256, FF = 2816;
constexpr int NWAVES = 8, NTHREADS = 512;
constexpr float EPS = 1e-6f;
constexpr size_t MiB = (size_t)1 << 20;
constexpr size_t WS_SSY = 0, WS_SSH1 = 65536, WS_SSH2 = 131072, WS_BIAS1 = 196608;
constexpr size_t WS_SSO = 1 * MiB, WS_BG = 2 * MiB, WS_SSYP = 4 * MiB, WS_SSH2P = 5 * MiB;
constexpr size_t WS_W = 8 * MiB;
constexpr size_t WS_HBA = 44 * MiB, WS_HBB = 76 * MiB, WS_RA = 108 * MiB, WS_RB = 236 * MiB, WS_END = 364 * MiB;
constexpr size_t W_WIN = 0, W_WZ = 9 * MiB, W_WOUT = 13 * MiB, W_FFNIN = 17 * MiB, W_FFNOUT = 28 * MiB, W_PLE = 33 * MiB + MiB / 2, W_GATE = 34 * MiB;
constexpr size_t W_WQ = 0, W_WO = 3 * MiB, W_WK = 5 * MiB, W_WV = 7 * MiB, W_W1T = 8 * MiB, W_W2T = 10 * MiB;
constexpr size_t RB_Y = 0, RB_KBUF = 64 * MiB, RB_VT = 96 * MiB, RB_HID = 112 * MiB, RB_KC = 116 * MiB, RB_VCT = 118 * MiB, RB_PB = 120 * MiB;
constexpr int VT_LD = T + 64;
constexpr size_t RA_VT = 96 * MiB;
constexpr int LDS_TBL = 141312;
constexpr int LDS_XB = 141312 + 256;
constexpr int LDS_BYTES = 141312 + 256 + 64;
constexpr size_t WS_XBAR = 212992;
constexpr int NSA_WAVE_LDS = 17664;

template <class Tp> __device__ __forceinline__ Tp* lau(Tp* p) { asm volatile("" : "+s"(p)); return p; }
__device__ __forceinline__ int lauv0() { int v = 0; asm volatile("" : "+v"(v)); return v; }
__device__ __forceinline__ int my_lane() { return (int)__builtin_amdgcn_mbcnt_hi(~0u, __builtin_amdgcn_mbcnt_lo(~0u, (unsigned)lauv0())); }
__device__ __forceinline__ int hw_slot() { return (int)(__builtin_amdgcn_s_getreg((5 << 11) | 4) & 0x3Fu); }
__device__ __forceinline__ int my_wave(LAS unsigned char* lds) { return __builtin_amdgcn_readfirstlane(((LAS int*)(lds + LDS_TBL))[hw_slot()]); }
__device__ __forceinline__ int lauv(int v) { asm volatile("" : "+v"(v)); return v; }
__device__ __forceinline__ int laus(int v) { asm volatile("" : "+s"(v)); return v; }
__device__ __forceinline__ unsigned cvt_pk_bf16(float lo, float hi) { unsigned r; asm volatile("v_cvt_pk_bf16_f32 %0, %1, %2" : "=v"(r) : "v"(lo), "v"(hi)); return r; }
__device__ __forceinline__ float bf2f(unsigned short b) { return __uint_as_float((unsigned)b << 16); }
__device__ __forceinline__ void st_bf4(bf16_t* p, f32x4 v) { u32x2 w; w.x = cvt_pk_bf16(v[0], v[1]); w.y = cvt_pk_bf16(v[2], v[3]); *(u32x2*)p = w; }
__device__ __forceinline__ f32x4 ld_bf4(const bf16_t* p) { u32x2 w = *(const u32x2*)p; f32x4 r; r[0] = __uint_as_float(w.x << 16); r[1] = __uint_as_float(w.x & 0xffff0000u); r[2] = __uint_as_float(w.y << 16); r[3] = __uint_as_float(w.y & 0xffff0000u); return r; }
__device__ __forceinline__ float sigmoidf_(float x) { return __builtin_amdgcn_rcpf(1.f + __builtin_amdgcn_exp2f(x * -1.44269504f)); }
__device__ __forceinline__ float siluf_(float x) { return x * __builtin_amdgcn_rcpf(1.f + __builtin_amdgcn_exp2f(x * -1.44269504f)); }
__device__ __forceinline__ float shx(float v, int o, int lane) { return __builtin_bit_cast(float, __builtin_amdgcn_ds_bpermute((lane ^ o) << 2, __builtin_bit_cast(int, v))); }
template <int CTRL> __device__ __forceinline__ float dpp_f(float v) { return __builtin_bit_cast(float, __builtin_amdgcn_update_dpp(__builtin_bit_cast(int, v), __builtin_bit_cast(int, v), CTRL, 0xf, 0xf, false)); }
template <int CTRL> __device__ __forceinline__ unsigned dpp_u(unsigned v) { return (unsigned)__builtin_amdgcn_update_dpp((int)v, (int)v, CTRL, 0xf, 0xf, false); }
__device__ __forceinline__ float row_sum16(float v) { v += dpp_f<0xB1>(v); v += dpp_f<0x4E>(v); v += dpp_f<0x141>(v); v += dpp_f<0x140>(v); return v; }
__device__ __forceinline__ unsigned umax_(unsigned a, unsigned b) { return a > b ? a : b; }
__device__ __forceinline__ float readlane_f(float v, int l) { return __builtin_bit_cast(float, __builtin_amdgcn_readlane(__builtin_bit_cast(int, v), l)); }
__device__ __forceinline__ float wave_sum(float v) { v = row_sum16(v); return readlane_f(v, 0) + readlane_f(v, 16) + readlane_f(v, 32) + readlane_f(v, 48); }
__device__ __forceinline__ unsigned wave_max_u32(unsigned v) {
    v = umax_(v, dpp_u<0xB1>(v)); v = umax_(v, dpp_u<0x4E>(v)); v = umax_(v, dpp_u<0x141>(v)); v = umax_(v, dpp_u<0x140>(v));
    const unsigned a = (unsigned)__builtin_amdgcn_readlane((int)v, 0), b = (unsigned)__builtin_amdgcn_readlane((int)v, 16), c = (unsigned)__builtin_amdgcn_readlane((int)v, 32), d = (unsigned)__builtin_amdgcn_readlane((int)v, 48);
    return umax_(umax_(a, b), umax_(c, d));
}

namespace pg8 {
constexpr int BM = 256, BK = 64, HALF = 128, HTB = HALF * BK * 2, STAGE_BYTES = 8 * HTB, NXCD = 8, WGM = 8;
__host__ __device__ __forceinline__ int lds_byte(int r, int c) { const int st = (r >> 4) * 2 + (c >> 5), rr = r & 15, cc = c & 31, ob = rr * 64 + cc * 2; return st * 1024 + (ob ^ (((ob >> 9) & 1) << 5)); }
__host__ __device__ __forceinline__ void stage_rc(int b, int& R, int& C) { const int st = b / 1024, sb = b % 1024, swz = sb ^ (((sb >> 9) & 1) << 5); R = (st >> 1) * 16 + swz / 64; C = (st & 1) * 32 + (swz % 64) / 2; }
struct Unit { int pm, pn; };
struct Gemm { const bf16_t* A; const bf16_t* Bt; int M, N, K, lda, ldb; };
struct StaticOrder {
    int nM, nN, nwg, G, c;
    __device__ void init(int M, int N, int G_, int c_) { nM = M / BM; nN = N / BM; nwg = nM * nN; G = G_; c = c_; }
    __device__ bool next(int i, Unit& u) const {
        const long L = (long)i * G + c; if (L >= nwg) return false;
        int wgid = (int)L; { const int q = nwg / NXCD, r = nwg % NXCD, xcd = wgid % NXCD, off = wgid / NXCD; wgid = (xcd < r ? xcd * (q + 1) : r * (q + 1) + (xcd - r) * q) + off; }
        const int nig = WGM * nN, gid = wgid / nig, fm = gid * WGM, gsz = (nM - fm) < WGM ? (nM - fm) : WGM;
        u.pm = fm + ((wgid % nig) % gsz); u.pn = (wgid % nig) / gsz; return true;
    }
};
template <class F> struct EpiFn {
    F f;
    __device__ __forceinline__ void operator()(const f32x4 (&acc)[2][2][4][2], const Unit& u, int wr, int wc, int fr, int fq) const {
#pragma unroll
        for (int ai = 0; ai < 2; ++ai)
#pragma unroll
            for (int m = 0; m < 4; ++m) { const int row = u.pm * BM + ai * HALF + wr * 64 + m * 16 + fr;
#pragma unroll
                for (int bj = 0; bj < 2; ++bj) f(row, u.pn * BM + bj * HALF + wc * 32 + 4 * fq, acc[ai][bj][m][0], acc[ai][bj][m][1]); }
    }
};
template <class G> struct EpiSS {
    G g; float* Y; float* ss; int ldc;
    __device__ __forceinline__ void operator()(const f32x4 (&acc)[2][2][4][2], const Unit& u, int wr, int wc, int fr, int fq) const {
#pragma unroll
        for (int ai = 0; ai < 2; ++ai)
#pragma unroll
            for (int m = 0; m < 4; ++m) { const int row = u.pm * BM + ai * HALF + wr * 64 + m * 16 + fr; float s = 0.f;
#pragma unroll
                for (int bj = 0; bj < 2; ++bj) { const int cb = u.pn * BM + bj * HALF + wc * 32 + 4 * fq; f32x4 o0 = acc[ai][bj][m][0], o1 = acc[ai][bj][m][1];
                    g(row, cb, o0, o1);
                    *(f32x4*)(Y + (size_t)row * ldc + cb) = o0; *(f32x4*)(Y + (size_t)row * ldc + cb + 16) = o1;
                    s += (o0[0] * o0[0] + o0[1] * o0[1]) + (o0[2] * o0[2] + o0[3] * o0[3]) + (o1[0] * o1[0] + o1[1] * o1[1]) + (o1[2] * o1[2] + o1[3] * o1[3]); }
                s += shx(s, 16, fq * 16 + fr); s += shx(s, 32, fq * 16 + fr);
                if (fq == 0) ss[(size_t)row * 16 + u.pn * 4 + wc] = s; }
    }
};

template <class Epi>
__device__ __forceinline__ void gemm_phase(LAS unsigned char* lds, const Gemm g, const StaticOrder& S, const Epi& E) {
    const int lane = lauv(my_lane()), wid = laus(my_wave(lds)), tid = wid * 64 + lane, wr = wid >> 2, wc = wid & 3, fr = lane & 15, fq = lane >> 4;
    const int K = g.K, nt = K / BK;
    unsigned voffA[2], voffB[2];
#pragma unroll
    for (int i = 0; i < 2; ++i) { int R, C; stage_rc(tid * 16 + i * 8192, R, C);
        voffA[i] = (unsigned)(R * g.lda + C) * 2u; voffB[i] = (unsigned)(R * g.ldb + C) * 2u; }
    const size_t kstep = (size_t)(BK * 2);
    const size_t hA = (size_t)HALF * g.lda * 2, hB = (size_t)HALF * g.ldb * 2;
    const size_t tA = 2 * hA, tB = 2 * hB;
    const unsigned ldsw = (unsigned)wid * 1024u;
    const int aoff = lds_byte(wr * 64 + fr, fq * 8), boff = lds_byte(wc * 32 + fr, fq * 8);
#define PG8_SA(b, h) (((b) * 2 + (h)) * HTB)
#define PG8_SB(b, h) ((4 + (b) * 2 + (h)) * HTB)
#define PG8_STAGE(bufoff, gbase, voff) do { _Pragma("unroll") for (int _i = 0; _i < 2; ++_i) \
        __builtin_amdgcn_global_load_lds((const unsigned*)((const char*)(gbase) + (voff)[_i]), (LAS unsigned*)(lds + (bufoff) + ldsw + _i * 8192), 16, 0, 0); } while (0)
#define PG8_LDA(dst, b, h) do { _Pragma("unroll") for (int m = 0; m < 4; ++m) _Pragma("unroll") for (int k = 0; k < 2; ++k) dst[m][k] = *(const LAS bf16x8*)(lds + PG8_SA(b, h) + aoff + m * 2048 + k * 1024); } while (0)
#define PG8_LDB(dst, b, h) do { _Pragma("unroll") for (int n = 0; n < 2; ++n) _Pragma("unroll") for (int k = 0; k < 2; ++k) dst[n][k] = *(const LAS bf16x8*)(lds + PG8_SB(b, h) + boff + n * 2048 + k * 1024); } while (0)
#define PG8_MMA(ai, bj, At, Bt) do { __builtin_amdgcn_s_setprio(1); _Pragma("unroll") for (int m = 0; m < 4; ++m) _Pragma("unroll") for (int n = 0; n < 2; ++n) _Pragma("unroll") for (int k = 0; k < 2; ++k) \
        acc[ai][bj][m][n] = __builtin_amdgcn_mfma_f32_16x16x32_bf16(Bt[n][k], At[m][k], acc[ai][bj][m][n], 0, 0, 0); __builtin_amdgcn_s_setprio(0); } while (0)
#define PG8_WAIT_V(n) asm volatile("s_waitcnt vmcnt(" #n ")" ::: "memory")
#define PG8_WAIT_L(n) asm volatile("s_waitcnt lgkmcnt(" #n ")" ::: "memory")
#define PG8_BAR __builtin_amdgcn_s_barrier()
#define PG8_SCHED __builtin_amdgcn_sched_barrier(0)
    Unit cur, nxt; int ui = 0;
    if (!S.next(0, cur)) return;
    f32x4 acc[2][2][4][2];
#pragma unroll
    for (int a = 0; a < 2; ++a)
#pragma unroll
        for (int b = 0; b < 2; ++b)
#pragma unroll
            for (int m = 0; m < 4; ++m)
#pragma unroll
                for (int n = 0; n < 2; ++n) acc[a][b][m][n] = (f32x4){0.f, 0.f, 0.f, 0.f};
    bf16x8 At[4][2], B0[2][2], B1[2][2];
    const char* cA = (const char*)g.A + (size_t)cur.pm * tA; const char* cB = (const char*)g.Bt + (size_t)cur.pn * tB;
    PG8_STAGE(PG8_SB(0, 0), cB, voffB); PG8_STAGE(PG8_SB(0, 1), cB + hB, voffB); PG8_STAGE(PG8_SA(0, 0), cA, voffA); PG8_STAGE(PG8_SA(0, 1), cA + hA, voffA);
    if (wr == 1) PG8_BAR;
    PG8_WAIT_V(2); PG8_BAR;
    PG8_STAGE(PG8_SB(1, 0), cB + kstep, voffB); PG8_STAGE(PG8_SA(1, 0), cA + kstep, voffA); PG8_STAGE(PG8_SB(1, 1), cB + hB + kstep, voffB);
    PG8_WAIT_V(6); PG8_BAR;
    for (;;) {
        const bool has_next = S.next(ui + 1, nxt);
        const char* nA = has_next ? (const char*)g.A + (size_t)nxt.pm * tA : cA; const char* nB = has_next ? (const char*)g.Bt + (size_t)nxt.pn * tB : cB;
        for (int t = 0; t < nt; t += 2) {
            const bool last = (t == nt - 2);
            const char* a1 = cA + (size_t)(t + 1) * kstep;
            const char* a2 = last ? nA : cA + (size_t)(t + 2) * kstep; const char* b2 = last ? nB : cB + (size_t)(t + 2) * kstep;
            const char* a3 = a2 + kstep; const char* b3 = b2 + kstep;
            PG8_LDB(B0, 0, 0); PG8_LDB(B1, 0, 1); PG8_SCHED; PG8_LDA(At, 0, 0); PG8_STAGE(PG8_SA(1, 1), a1 + hA, voffA);
            PG8_WAIT_V(8); PG8_WAIT_L(0); PG8_BAR; PG8_MMA(0, 0, At, B0); PG8_MMA(0, 1, At, B1); PG8_BAR; PG8_SCHED;
            PG8_LDA(At, 0, 1); PG8_STAGE(PG8_SB(0, 0), b2, voffB); PG8_STAGE(PG8_SB(0, 1), b2 + hB, voffB); PG8_STAGE(PG8_SA(0, 0), a2, voffA);
            PG8_WAIT_V(8); PG8_WAIT_L(0); PG8_BAR; PG8_MMA(1, 0, At, B0); PG8_MMA(1, 1, At, B1); PG8_BAR; PG8_SCHED;
            PG8_LDB(B0, 1, 0); PG8_LDB(B1, 1, 1); PG8_SCHED; PG8_LDA(At, 1, 0); PG8_STAGE(PG8_SA(0, 1), a2 + hA, voffA);
            PG8_WAIT_V(8); PG8_WAIT_L(0); PG8_BAR; PG8_MMA(0, 0, At, B0); PG8_MMA(0, 1, At, B1); PG8_BAR; PG8_SCHED;
            PG8_LDA(At, 1, 1); PG8_STAGE(PG8_SB(1, 0), b3, voffB); PG8_STAGE(PG8_SB(1, 1), b3 + hB, voffB); PG8_STAGE(PG8_SA(1, 0), a3, voffA);
            PG8_WAIT_V(8); PG8_WAIT_L(0); PG8_BAR; PG8_MMA(1, 0, At, B0); PG8_MMA(1, 1, At, B1); PG8_BAR; PG8_SCHED;
        }
        if (wr == 0) PG8_BAR;
        { const int l2 = lauv(my_lane()), w2 = laus(my_wave(lds)); E(acc, cur, w2 >> 2, w2 & 3, l2 & 15, l2 >> 4); }
        if (!has_next) break;
#pragma unroll
        for (int a = 0; a < 2; ++a)
#pragma unroll
            for (int b = 0; b < 2; ++b)
#pragma unroll
                for (int m = 0; m < 4; ++m)
#pragma unroll
                    for (int n = 0; n < 2; ++n) acc[a][b][m][n] = (f32x4){0.f, 0.f, 0.f, 0.f};
        cur = nxt; cA = nA; cB = nB; ++ui;
        if (wr == 1) PG8_BAR;
    }
    PG8_WAIT_V(0);
    PG8_BAR;
#undef PG8_SA
#undef PG8_SB
#undef PG8_STAGE
#undef PG8_LDA
#undef PG8_LDB
#undef PG8_MMA
#undef PG8_WAIT_V
#undef PG8_WAIT_L
#undef PG8_BAR
#undef PG8_SCHED
}
}

struct Params {
    const float *x, *p, *mix_pre, *mix_post, *ffn_pre, *ffn_post, *gdn_w_in, *gdn_conv_w, *gdn_a_log, *gdn_dt_bias, *gdn_o_norm, *gdn_w_out,
        *kv_norm, *kv_w, *cmp_pos, *cmp_w1, *cmp_w2, *nsa_w_qg, *nsa_w_o, *ffn_w_in, *ffn_w_out, *ple_w_in, *ple_w_gate;
    float* out; unsigned char* ws;
};
typedef const __attribute__((address_space(4))) Params* KP;


#define XB_TMO      128
#define XB_XCNT(j)  (256  + 64 * (j))
#define XB_XSUB(j)  (1280 + 64 * (j))
#define XB_XGEN(j)  (2304 + 64 * (j))
#define XB_TOP      3328
#define XB_TOPGEN   3392
#define XB_SPIN_CAP (1u << 22)
__device__ __forceinline__ unsigned xb_ld(unsigned* p)              { return __hip_atomic_load(p, __ATOMIC_RELAXED, __HIP_MEMORY_SCOPE_AGENT); }
__device__ __forceinline__ unsigned xb_add(unsigned* p, unsigned v) { return __hip_atomic_fetch_add(p, v, __ATOMIC_RELAXED, __HIP_MEMORY_SCOPE_AGENT); }
__device__ __forceinline__ unsigned xb_xcc_id() { return (unsigned)__builtin_amdgcn_s_getreg((3 << 11) | 20) & 0xFu; }
#define XB_SPIN(cond, bar) do { unsigned _sp = 0; while (cond) { __builtin_amdgcn_s_sleep(1); \
    if ((++_sp & 255u) == 0u) { if (xb_ld(&(bar)[XB_TMO])) break; if (_sp > XB_SPIN_CAP) { atomicAdd(&(bar)[XB_TMO], 1u); break; } } } } while (0)
__device__ __forceinline__ void xcd_barrier_complete(unsigned* bar, unsigned x, unsigned& nloc, unsigned& nx) {
    const unsigned Gn = gridDim.x;
    unsigned sum, cnt, mine, sp = 0u;
    for (;;) {
        sum = 0u; cnt = 0u; mine = 0u;
#pragma unroll
        for (unsigned j = 0; j < 16; ++j) { const unsigned c = xb_ld(&bar[XB_XCNT(j)]); sum += c; cnt += (c > 0u) ? 1u : 0u; mine = (j == x) ? c : mine; }
        if (sum == Gn) break;
        __builtin_amdgcn_s_sleep(1);
        if ((++sp & 255u) == 0u) { if (xb_ld(&bar[XB_TMO])) break; if (sp > XB_SPIN_CAP) { atomicAdd(&bar[XB_TMO], 1u); break; } }
    }
    nloc = mine > 0u ? mine : 1u; nx = cnt > 0u ? cnt : 1u;
}
__device__ __forceinline__ void xcd_grid_barrier(KP P, LAS unsigned char* lds) {
    asm volatile("s_waitcnt vmcnt(0) lgkmcnt(0)" ::: "memory");
    __syncthreads();
    if (laus(my_wave(lds)) == 0 && lauv(my_lane()) == 0) {
        unsigned* bar = (unsigned*)(lau(lau(P)->ws) + WS_XBAR);
        volatile LAS unsigned* st = (volatile LAS unsigned*)(lds + LDS_XB);
        const unsigned x = xb_xcc_id();
        __builtin_amdgcn_s_waitcnt(0);
        const unsigned nloc = st[0], nx = st[1];
        const unsigned old = xb_add(&bar[XB_XSUB(x)], 1u);
        const unsigned gen = old / nloc;
        if (old + 1u == (gen + 1u) * nloc) {
            __builtin_amdgcn_fence(__ATOMIC_RELEASE, "agent");
            asm volatile("s_waitcnt vmcnt(0)" ::: "memory");
            const unsigned og = xb_add(&bar[XB_TOP], 1u);
            const unsigned tg = og / nx;
            if (og + 1u == (tg + 1u) * nx) xb_add(&bar[XB_TOPGEN], 1u);
            else XB_SPIN(xb_ld(&bar[XB_TOPGEN]) == tg, bar);
            __builtin_amdgcn_fence(__ATOMIC_ACQUIRE, "agent");
            xb_add(&bar[XB_XGEN(x)], 1u);
            asm volatile("s_waitcnt vmcnt(0)" ::: "memory");
        } else {
            XB_SPIN(xb_ld(&bar[XB_XGEN(x)]) == gen, bar);
            __builtin_amdgcn_fence(__ATOMIC_ACQUIRE, "agent");
            asm volatile("s_waitcnt vmcnt(0)" ::: "memory");
        }
    }
    __syncthreads();
}

__device__ __forceinline__ int ffn_row(int n) { const int up = n >= FF ? 1 : 0, hid = n - up * FF; const int pn = hid >> 7, r = hid & 127; return 256 * pn + 128 * (r >> 6) + 32 * ((r & 63) >> 4) + 16 * up + (r & 15); }
__device__ __noinline__ int cv_job_(const float* W, int K, int N, int n_lo, int n_hi, const float* gain, bf16_t* WT, int row_off, int mode, LAS float* scr, int gw, int ngw, int base, int lane, float mul) {
    const int nblk = (n_hi - n_lo + 31) / 32, items = (K / 64) * nblk;
    int first = (gw - base % ngw + ngw) % ngw;
    for (int it = first; it < items; it += ngw) {
        const int kb = it / nblk, nb = it % nblk, k0 = 64 * kb, n0 = n_lo + 32 * nb;
#pragma unroll 8
        for (int i = 0; i < 32; ++i) { const int kk = 2 * i + (lane >> 5), n = n0 + (lane & 31); float v = (n < n_hi) ? W[(size_t)(k0 + kk) * N + n] : 0.f; if (gain) v *= gain[k0 + kk]; scr[kk * 33 + (lane & 31)] = v * mul; }
        asm volatile("s_waitcnt lgkmcnt(0)" ::: "memory");
        const int c = lane & 7;
#pragma unroll
        for (int j = 0; j < 4; ++j) { const int nl = (lane >> 3) + 8 * j, n = n0 + nl; const LAS float* s = scr + (8 * c) * 33 + nl;
            u32x4 o; o.x = cvt_pk_bf16(s[0 * 33], s[1 * 33]); o.y = cvt_pk_bf16(s[2 * 33], s[3 * 33]); o.z = cvt_pk_bf16(s[4 * 33], s[5 * 33]); o.w = cvt_pk_bf16(s[6 * 33], s[7 * 33]);
            if (n < n_hi) { const int row = mode ? ffn_row(n) : row_off + (n - n_lo); *(u32x4*)(WT + (size_t)row * K + k0 + 8 * c) = o; } }
        asm volatile("s_waitcnt lgkmcnt(0)" ::: "memory");
    }
    return base + items;
}
#define cv_job(W_, K_, N_, lo_, hi_, g_, WT_, ro_, mode_, scr_, gw_, ngw_, base_, lane_, ...) base_ = cv_job_(W_, K_, N_, lo_, hi_, g_, WT_, ro_, mode_, scr_, gw_, ngw_, base_, lane_, (1.f, ##__VA_ARGS__))
__device__ __forceinline__ void zero_bf16(bf16_t* p, size_t n, int gtid, int gthreads) {
    const unsigned z = (unsigned)lauv(0);
    for (size_t i = (size_t)gtid * 8; i < n; i += (size_t)gthreads * 8) *(u32x4*)(p + i) = (u32x4){z, z, z, z};
}

__device__ __forceinline__ void convert_layer(KP P, int li, LAS unsigned char* lds) {
    P = lau(P);
    const int lane = lauv(my_lane()), wave = laus(my_wave(lds)), ngw = gridDim.x * NWAVES, gw = blockIdx.x * NWAVES + wave;
    LAS float* scr = (LAS float*)(lds + wave * 16384);
    unsigned char* wb = lau(lau(P)->ws) + WS_W;
    int base = 0;
    const int gtid = gw * 64 + lane, gthreads = ngw * 64;
    if (li < 2) {
        const float* win = P->gdn_w_in + (size_t)li * D * 6176; const float* gain = P->mix_pre + li * D;
        cv_job(win, D, 6176, 0, 4096, gain, (bf16_t*)(wb + W_WIN), 0, 0, scr, gw, ngw, base, lane);
        cv_job(win, D, 6176, 4096, 6144, gain, (bf16_t*)(wb + W_WZ), 0, 0, scr, gw, ngw, base, lane);
        cv_job(win, D, 6176, 6144, 6176, gain, (bf16_t*)(wb + W_WIN), 4096, 0, scr, gw, ngw, base, lane);
        zero_bf16((bf16_t*)(wb + W_WIN) + (size_t)4128 * D, (size_t)(4352 - 4128) * D, gtid, gthreads);
        cv_job(P->gdn_w_out + (size_t)li * 2048 * D, 2048, D, 0, D, nullptr, (bf16_t*)(wb + W_WOUT), 0, 0, scr, gw, ngw, base, lane);
    } else {
        const int j = li - 2;
        cv_job(P->nsa_w_qg + (size_t)j * D * 1072, D, 1072, 0, 1024, P->mix_pre + li * D, (bf16_t*)(wb + W_WQ), 0, 0, scr, gw, ngw, base, lane, 0.125f);
        cv_job(P->nsa_w_qg + (size_t)j * D * 1072, D, 1072, 1024, 1072, P->mix_pre + li * D, (bf16_t*)(wb + W_WQ), 1024, 0, scr, gw, ngw, base, lane);
        zero_bf16((bf16_t*)(wb + W_WQ) + (size_t)1072 * D, (size_t)(1280 - 1072) * D, gtid, gthreads);
        cv_job(P->nsa_w_o + (size_t)j * D * D, D, D, 0, D, nullptr, (bf16_t*)(wb + W_WO), 0, 0, scr, gw, ngw, base, lane);
        if (li == 2) {
            bf16_t* wk = (bf16_t*)(wb + W_WK); bf16_t* wv = (bf16_t*)(wb + W_WV);
            cv_job(P->kv_w, D, 1536, 0, 768, P->kv_norm, wk, 0, 0, scr, gw, ngw, base, lane);
            cv_job(P->kv_w, D, 1536, 768, 1024, P->kv_norm, wv, 0, 0, scr, gw, ngw, base, lane);
            cv_job(P->kv_w, D, 1536, 1024, 1280, P->kv_norm, wk, 768, 0, scr, gw, ngw, base, lane);
            cv_job(P->kv_w, D, 1536, 1280, 1536, P->kv_norm, wv, 256, 0, scr, gw, ngw, base, lane);
            for (int idx = 0; idx < 2; ++idx) {
                cv_job(P->cmp_w1 + (size_t)idx * 2048 * 256, 2048, 256, 0, 256, nullptr, (bf16_t*)(wb + W_W1T) + (size_t)idx * 256 * 2048, 0, 0, scr, gw, ngw, base, lane);
                cv_job(P->cmp_w2 + (size_t)idx * 256 * 64, 256, 64, 0, 64, nullptr, (bf16_t*)(wb + W_W2T) + (size_t)idx * 256 * 256, 0, 0, scr, gw, ngw, base, lane);
                zero_bf16((bf16_t*)(wb + W_W2T) + (size_t)idx * 256 * 256 + 64 * 256, (size_t)192 * 256, gtid, gthreads);
            }
        }
    }
    cv_job(P->ffn_w_in + (size_t)li * D * 2 * FF, D, 2 * FF, 0, 2 * FF, P->ffn_pre + li * D, (bf16_t*)(wb + W_FFNIN), 0, 1, scr, gw, ngw, base, lane);
    cv_job(P->ffn_w_out + (size_t)li * FF * D, FF, D, 0, D, nullptr, (bf16_t*)(wb + W_FFNOUT), 0, 0, scr, gw, ngw, base, lane);
    cv_job(P->ple_w_in + (size_t)li * PLE * D, PLE, D, 0, D, nullptr, (bf16_t*)(wb + W_PLE), 0, 0, scr, gw, ngw, base, lane);
    cv_job(P->ple_w_gate + (size_t)li * D * D, D, D, 0, D, nullptr, (bf16_t*)(wb + W_GATE), 0, 0, scr, gw, ngw, base, lane);
}
__device__ __forceinline__ void cmp_bias(KP P, LAS unsigned char* lds) {
    P = lau(P);
    const int lane = lauv(my_lane()), wave = laus(my_wave(lds));
    if (blockIdx.x >= 2) return;
    const int idx = blockIdx.x;
    const float* w1 = P->cmp_w1 + (size_t)idx * 2048 * 256; const float* pos = P->cmp_pos + idx * 2048;
    f32x4 a = (f32x4){0.f, 0.f, 0.f, 0.f};
    for (int k = wave * 256; k < wave * 256 + 256; ++k) { const f32x4 w = *(const f32x4*)(w1 + (size_t)k * 256 + lane * 4); a += w * pos[k]; }
    LAS f32x4* part = (LAS f32x4*)lds;
    __syncthreads();
    part[wave * 64 + lane] = a;
    __syncthreads();
    if (wave == 0) { f32x4 s = part[lane]; for (int w = 1; w < 8; ++w) s += part[w * 64 + lane]; *(f32x4*)((float*)(lau(lau(P)->ws) + WS_BIAS1) + idx * 256 + lane * 4) = s; }
    __syncthreads();
}

__device__ __forceinline__ void rows_phase(KP P, int mode, int li, bf16_t* hb, const float* gpost, const float* Y, LAS unsigned char* lds) {
    P = lau(P);
    const int lane = lauv(my_lane()), wave = laus(my_wave(lds)), ngw = gridDim.x * NWAVES, gw = blockIdx.x * NWAVES + wave;
    unsigned char* ws = lau(lau(P)->ws);
    float* ssh1 = (float*)(ws + WS_SSH1); float* ssh2 = (float*)(ws + WS_SSH2);
    for (int r = gw; r < T; r += ngw) {
        f32x4 h[4]; float s = 0.f;
        if (mode == 0) {
#pragma unroll
            for (int j = 0; j < 4; ++j) h[j] = *(const f32x4*)(P->x + (size_t)r * D + 4 * lane + 256 * j);
        } else {
            float ssv = ((const float*)(ws + WS_SSYP))[(size_t)r * 16 + (lane & 15)]; ssv = row_sum16(ssv);
            const float rr = rsqrtf(ssv * (1.f / D) + EPS);
#pragma unroll
            for (int j = 0; j < 4; ++j) { const int c = 4 * lane + 256 * j; const f32x4 y = *(const f32x4*)(Y + (size_t)r * D + c), g = *(const f32x4*)(gpost + c), h0 = *(const f32x4*)(P->out + (size_t)r * D + c); h[j] = h0 + y * rr * g; }
        }
#pragma unroll
        for (int j = 0; j < 4; ++j) { const int c = 4 * lane + 256 * j; *(f32x4*)(P->out + (size_t)r * D + c) = h[j]; st_bf4(hb + (size_t)r * D + c, h[j]);
            s += (h[j][0] * h[j][0] + h[j][1] * h[j][1]) + (h[j][2] * h[j][2] + h[j][3] * h[j][3]); }
        s = wave_sum(s);
        if (lane == 0) { if (mode == 0) ssh2[r] = s; else if (mode == 1) ssh1[r] = s; }
        if (mode == 2) { const f32x4 pv = *(const f32x4*)(P->p + ((size_t)li * T + r) * PLE + 4 * lane); st_bf4((bf16_t*)(ws + WS_RB + RB_PB) + (size_t)r * PLE + 4 * lane, pv); }
    }
}

__device__ __forceinline__ bf16x8 ldg16(const bf16_t* p) { return *(const bf16x8*)p; }
__device__ __forceinline__ bf16x8 pack8(const f32x4& a, const f32x4& b) { u32x4 w; w.x = cvt_pk_bf16(a[0], a[1]); w.y = cvt_pk_bf16(a[2], a[3]); w.z = cvt_pk_bf16(b[0], b[1]); w.w = cvt_pk_bf16(b[2], b[3]); return __builtin_bit_cast(bf16x8, w); }
#define MFMA16(a, b, c) __builtin_amdgcn_mfma_f32_16x16x32_bf16((a), (b), (c), 0, 0, 0)

__device__ __forceinline__ void gdn_conv_phase(KP P, int li, LAS unsigned char* lds) {
    P = lau(P);
    const int lane = lauv(my_lane()), wave = laus(my_wave(lds)), ngw = gridDim.x * NWAVES, gw = blockIdx.x * NWAVES + wave;
    unsigned char* ws = lau(lau(P)->ws);
    const bf16_t* src = (const bf16_t*)(ws + WS_RA); bf16_t* dst = (bf16_t*)(ws + WS_RB);
    float* bg = (float*)(ws + WS_BG);
    const float* cw = P->gdn_conv_w + (size_t)li * 4 * 4096;
    for (int rb = gw; rb < T / 8; rb += ngw) {
        const int t0 = rb * 8;
        for (int ci = 0; ci < 8; ++ci) {
            const int c0 = 512 * ci + 8 * lane;
            f32x4 w[4][2];
#pragma unroll
            for (int j = 0; j < 4; ++j) { w[j][0] = *(const f32x4*)(cw + j * 4096 + c0); w[j][1] = *(const f32x4*)(cw + j * 4096 + c0 + 4); }
            f32x4 xa[3][2];
#pragma unroll
            for (int j = 0; j < 3; ++j) { const int t = t0 - 3 + j;
                if (t >= 0) { xa[j][0] = ld_bf4(src + (size_t)t * 4096 + c0); xa[j][1] = ld_bf4(src + (size_t)t * 4096 + c0 + 4); } else { xa[j][0] = (f32x4){0.f, 0.f, 0.f, 0.f}; xa[j][1] = xa[j][0]; } }
#pragma unroll
            for (int tt = 0; tt < 8; ++tt) { const int t = t0 + tt;
                f32x4 x3[2]; x3[0] = ld_bf4(src + (size_t)t * 4096 + c0); x3[1] = ld_bf4(src + (size_t)t * 4096 + c0 + 4);
                f32x4 y[2]; float ss = 0.f;
#pragma unroll
                for (int hh = 0; hh < 2; ++hh) { y[hh] = xa[0][hh] * w[0][hh] + xa[1][hh] * w[1][hh] + xa[2][hh] * w[2][hh] + x3[hh] * w[3][hh];
#pragma unroll
                    for (int e = 0; e < 4; ++e) { y[hh][e] = siluf_(y[hh][e]); ss += y[hh][e] * y[hh][e]; } }
                if (ci < 4) { ss = row_sum16(ss); float sc = rsqrtf(ss + 1e-6f); if (ci < 2) sc *= 0.08838834764831845f; y[0] = y[0] * sc; y[1] = y[1] * sc; }
                u32x4 o; o.x = cvt_pk_bf16(y[0][0], y[0][1]); o.y = cvt_pk_bf16(y[0][2], y[0][3]); o.z = cvt_pk_bf16(y[1][0], y[1][1]); o.w = cvt_pk_bf16(y[1][2], y[1][3]);
                *(u32x4*)(dst + (size_t)t * 4096 + c0) = o;
                xa[0][0] = xa[1][0]; xa[0][1] = xa[1][1]; xa[1][0] = xa[2][0]; xa[1][1] = xa[2][1]; xa[2][0] = x3[0]; xa[2][1] = x3[1]; }
        }
        if (lane < 16) {
            const float A = __expf(P->gdn_a_log[li * 16 + lane]), dtb = P->gdn_dt_bias[li * 16 + lane];
#pragma unroll
            for (int tt = 0; tt < 8; ++tt) { const int t = t0 + tt; const float bl = bg[t * 32 + lane], a = bg[t * 32 + 16 + lane] + dtb;
                const float sp = fmaxf(a, 0.f) + log1pf(__expf(-fabsf(a)));
                bg[t * 32 + lane] = sigmoidf_(bl); bg[t * 32 + 16 + lane] = -A * sp; }
        }
    }
}

__device__ __forceinline__ void gdn_scan_phase(KP P, LAS unsigned char* lds) {
    P = lau(P);
    const int lane = lauv(my_lane()), wave = laus(my_wave(lds));
    if (wave >= 2) return;
    const int id = blockIdx.x * 2 + wave; if (id >= 512) return;
    const int hv = id >> 5, cgp = id & 31, hq = hv >> 1, row = lane >> 4, part = lane & 15, e = 4 * cgp + row;
    unsigned char* ws = lau(lau(P)->ws);
    bf16_t* base = (bf16_t*)(ws + WS_RB);
    const bf16_t* qp = base + hq * 128 + 8 * part; const bf16_t* kp = base + 1024 + hq * 128 + 8 * part; bf16_t* vp = base + 2048 + hv * 128 + e;
    const float* ab = (const float*)(ws + WS_BG);
    float S[8];
#pragma unroll
    for (int i = 0; i < 8; ++i) S[i] = 0.f;
    u32x4 kr[2][4], qr[2][4]; unsigned short vr[2][4]; float be[2][4], al[2][4];
#define GS_LOAD(buf, tb) do { _Pragma("unroll") for (int u = 0; u < 4; ++u) { const size_t t = (size_t)((tb) + u); kr[buf][u] = *(const u32x4*)(kp + t * 4096); qr[buf][u] = *(const u32x4*)(qp + t * 4096); vr[buf][u] = vp[t * 4096]; be[buf][u] = ab[t * 32 + hv]; al[buf][u] = __expf(ab[t * 32 + 16 + hv]); } } while (0)
#define GS_COMP(buf, tb) do { _Pragma("unroll") for (int u = 0; u < 4; ++u) { const size_t t = (size_t)((tb) + u); \
        float kf[8], qf[8]; \
        _Pragma("unroll") for (int j = 0; j < 4; ++j) { kf[2 * j] = __uint_as_float(kr[buf][u][j] << 16); kf[2 * j + 1] = __uint_as_float(kr[buf][u][j] & 0xffff0000u); qf[2 * j] = __uint_as_float(qr[buf][u][j] << 16); qf[2 * j + 1] = __uint_as_float(qr[buf][u][j] & 0xffff0000u); } \
        float dot = 0.f; _Pragma("unroll") for (int i = 0; i < 8; ++i) dot += kf[i] * S[i]; \
        dot = row_sum16(dot); \
        const float a = al[buf][u], c = be[buf][u] * (bf2f(vr[buf][u]) - a * dot); \
        float od = 0.f; _Pragma("unroll") for (int i = 0; i < 8; ++i) { S[i] = a * S[i] + kf[i] * c; od += qf[i] * S[i]; } \
        od = row_sum16(od); \
        const unsigned ob = cvt_pk_bf16(od, od) & 0xffffu; \
        if (part == 0) vp[t * 4096] = (unsigned short)ob; } } while (0)
    GS_LOAD(0, 0);
    for (int tb = 0; tb < T; tb += 8) {
        GS_LOAD(1, tb + 4);
        GS_COMP(0, tb);
        if (tb + 8 < T) GS_LOAD(0, tb + 8);
        GS_COMP(1, tb + 4);
    }
#undef GS_LOAD
#undef GS_COMP
}


constexpr int GD_ITEM = 90112;
constexpr int GD_W = 0, GD_QD = 16384, GD_KDT = 32768, GD_QK = 49152, GD_U = 57344, GD_STEP = 57344;
constexpr size_t RA_SST = 120 * MiB;
constexpr int PREP_HALF_LDS = 53248;
constexpr int GD_WCH = 32, GD_NWIN = 256 / GD_WCH;
constexpr size_t GD_REGION = (size_t)16 * GD_WCH * GD_ITEM;
__device__ __forceinline__ int frag_off(int r, int c, int ksteps) { return (((r >> 4) * ksteps + (c >> 5)) * 64 + (((c & 15) >> 2) * 16) + (r & 15)) * 16 + (((c & 16) >> 2) + (c & 3)) * 2; }

__device__ __forceinline__ void gdn_prep_phase(KP P, int wi, LAS unsigned char* lds, int blk0, int nblk) {
    if ((int)blockIdx.x < blk0 || (int)blockIdx.x >= blk0 + nblk) return;
    P = lau(P);
    const int lane0 = lauv(my_lane()), wave = laus(my_wave(lds)), half = wave >> 2, w4 = wave & 3;
    unsigned char* ws = lau(P->ws);
    const bf16_t* qkv = (const bf16_t*)(ws + WS_RB); const float* ab = (const float*)(ws + WS_BG); float* glb = (float*)(ws + WS_SSY);
    unsigned char* items = ws + WS_RA + (size_t)(wi & 1) * GD_REGION;
    LAS unsigned char* hl = lds + half * PREP_HALF_LDS;
    LAS float* gcs = (LAS float*)hl; LAS float* bts = gcs + 64; LAS float* ebs = gcs + 128; LAS float* Lm = (LAS float*)(hl + 1024); LAS bf16_t* solb = (LAS bf16_t*)(hl + 1024 + 17408);
    const f32x4 z4 = (f32x4){0.f, 0.f, 0.f, 0.f};
    for (int it0 = ((int)blockIdx.x - blk0) * 2; it0 < 16 * GD_WCH; it0 += nblk * 2) {
        const int lane = lauv(lane0), tid4 = w4 * 64 + lane, fr = lane & 15, fq = lane >> 4;
        const int item = it0 + half, hv = item / GD_WCH, nl = item % GD_WCH, n = wi * GD_WCH + nl, t0 = n * 64, hq = hv >> 1;
        unsigned char* ib = items + (size_t)item * GD_ITEM;
        const bf16_t* qb = qkv + (size_t)t0 * 4096 + hq * 128; const bf16_t* kb = qb + 1024; const bf16_t* vb = qkv + (size_t)t0 * 4096 + 2048 + hv * 128;
        if (w4 == 0) { const float g = ab[(size_t)(t0 + lane) * 32 + 16 + hv]; bts[lane] = ab[(size_t)(t0 + lane) * 32 + hv]; gcs[lane] = g;
            asm volatile("s_waitcnt lgkmcnt(0)" ::: "memory");
            float sacc = 0.f;
            for (int i = 0; i < 64; ++i) { const float gi = gcs[i]; sacc += (i <= lane) ? gi : 0.f; }
            asm volatile("s_waitcnt lgkmcnt(0)" ::: "memory");
            gcs[lane] = sacc; ebs[lane] = bts[lane] * __expf(sacc);
            if (lane == 63) glb[hv * 256 + n] = __expf(sacc); }
        __syncthreads();
        { const int t = 16 * w4 + fr; const float gct = gcs[t], bt = bts[t];
          bf16x8 KT[4], QT[4];
#pragma unroll
          for (int kk = 0; kk < 4; ++kk) { KT[kk] = *(const bf16x8*)(kb + (size_t)t * 4096 + 32 * kk + 8 * fq); QT[kk] = *(const bf16x8*)(qb + (size_t)t * 4096 + 32 * kk + 8 * fq); }
          for (int nt = 0; nt < 4; ++nt) {
              f32x4 Lv = z4, qv = z4;
              if (nt <= w4) {
                  f32x4 aL = z4, aQ = z4;
#pragma unroll
                  for (int kk = 0; kk < 4; ++kk) { const bf16x8 X = *(const bf16x8*)(kb + (size_t)(16 * nt + fr) * 4096 + 32 * kk + 8 * fq); aL = MFMA16(X, KT[kk], aL); aQ = MFMA16(X, QT[kk], aQ); }
                  const f32x4 gs4 = *(const LAS f32x4*)(gcs + 16 * nt + 4 * fq);
#pragma unroll
                  for (int jj = 0; jj < 4; ++jj) { const int sx = 16 * nt + 4 * fq + jj; const float dec = __expf(gct - gs4[jj]); Lv[jj] = (sx < t) ? bt * aL[jj] * dec : 0.f; qv[jj] = (sx <= t) ? aQ[jj] * dec : 0.f; }
              }
              *(LAS f32x4*)(Lm + t * 68 + 16 * nt + 4 * fq) = Lv;
              st_bf4((bf16_t*)(ib + GD_QK + ((w4 * 2 + (nt >> 1)) * 64 + fq * 16 + fr) * 16 + (nt & 1) * 8), qv);
          } }
        { const float gl = gcs[63];
#pragma unroll
          for (int i = 0; i < 8; ++i) { const int p = tid4 + 256 * i, t = p >> 5, d4 = (p & 31) * 4; const float sc = __expf(gcs[t]);
              const f32x4 v = ld_bf4(qb + (size_t)t * 4096 + d4); st_bf4((bf16_t*)(ib + GD_QD + frag_off(t, d4, 4)), v * sc); }
#pragma unroll
          for (int i = 0; i < 8; ++i) { const int p = tid4 + 256 * i, dk = p & 127, t4 = (p >> 7) * 4; f32x4 v; const f32x4 gs4 = *(const LAS f32x4*)(gcs + t4);
#pragma unroll
              for (int e = 0; e < 4; ++e) v[e] = bf2f(kb[(size_t)(t4 + e) * 4096 + dk]) * __expf(gl - gs4[e]);
              st_bf4((bf16_t*)(ib + GD_KDT + frag_off(dk, t4, 2)), v); } }
        __syncthreads();
        { const int col = 64 * w4 + lane; float r[64];
          { const bf16_t* src = (w4 < 2) ? (vb + col) : (kb + col - 128); const LAS float* cf = (w4 < 2) ? bts : ebs;
#pragma unroll
            for (int i4 = 0; i4 < 16; ++i4) { const f32x4 c4 = *(const LAS f32x4*)(cf + 4 * i4);
#pragma unroll
                for (int e = 0; e < 4; ++e) r[4 * i4 + e] = bf2f(src[(size_t)(4 * i4 + e) * 4096]) * c4[e]; } }
#pragma unroll
          for (int i = 1; i < 64; ++i) {
#pragma unroll
              for (int j4 = 0; j4 < (i + 3) / 4; ++j4) { const f32x4 l = *(const LAS f32x4*)(Lm + i * 68 + 4 * j4);
#pragma unroll
                  for (int e = 0; e < 4; ++e) if (4 * j4 + e < i) r[i] -= l[e] * r[4 * j4 + e]; }
          }
#pragma unroll
          for (int i = 0; i < 64; ++i) solb[i * 264 + col] = (bf16_t)(cvt_pk_bf16(r[i], r[i]) & 0xffffu);
          if (w4 < 2) {
#pragma unroll
              for (int mt = 0; mt < 4; ++mt)
#pragma unroll
                  for (int q = 0; q < 4; ++q) *(f32x4*)(ib + GD_U + ((((col >> 4) * 4 + mt) * 64 + q * 16 + (col & 15)) * 16)) = (f32x4){r[16 * mt + 4 * q], r[16 * mt + 4 * q + 1], r[16 * mt + 4 * q + 2], r[16 * mt + 4 * q + 3]};
          }
        }
        __syncthreads();
#pragma unroll
        for (int i = 0; i < 8; ++i) { const int p = tid4 + 256 * i, t = p >> 5, d4 = (p & 31) * 4;
            *(u32x2*)(ib + GD_W + frag_off(t, d4, 4)) = *(const LAS u32x2*)(solb + t * 264 + 128 + d4); }
        __syncthreads();
    }
}

__device__ __forceinline__ void gdn_scan2_phase(KP P, int li, LAS unsigned char* lds) {
    P = lau(P);
    const int lane = lauv(my_lane()), wave = laus(my_wave(lds));
    if (wave != 0 || blockIdx.x >= 128) return;
    const int hv = blockIdx.x >> 3, slice = blockIdx.x & 7, fr = lane & 15, fq = lane >> 4;
    unsigned char* ws = lau(P->ws);
    unsigned* flags = (unsigned*)(ws + WS_XBAR + 16384) + (size_t)li * 16 * 64;
    const f32x4 z4 = (f32x4){0.f, 0.f, 0.f, 0.f};
    const float one = __builtin_bit_cast(float, lauv(0x3f800000));
    f32x4 Sacc[8]; bf16x8 Sop[4];
#pragma unroll
    for (int dt = 0; dt < 8; ++dt) Sacc[dt] = z4;
#pragma unroll
    for (int kk = 0; kk < 4; ++kk) Sop[kk] = pack8(Sacc[2 * kk], Sacc[2 * kk + 1]);
#define GS2_STAGE(slot, nl_) do { const unsigned char* gsrc = items + (size_t)(nl_) * GD_ITEM + lane * 16; \
        _Pragma("unroll") for (int f = 0; f < 56; ++f) __builtin_amdgcn_global_load_lds((const unsigned*)(gsrc + f * 1024), (LAS unsigned*)(lds + (slot) * GD_STEP + f * 1024), 16, 0, 0); } while (0)
#define GS2_LDU(dst, nl_) do { _Pragma("unroll") for (int mt = 0; mt < 4; ++mt) dst[mt] = *(const f32x4*)(items + (size_t)(nl_) * GD_ITEM + GD_U + ((slice * 4 + mt) * 64 + lane) * 16); } while (0)
    f32x4 ucur[4], unxt[4];
    for (int wi = 0; wi < GD_NWIN; ++wi) {
    const unsigned char* items = ws + WS_RA + (size_t)(wi & 1) * GD_REGION + (size_t)(hv * GD_WCH) * GD_ITEM; const float* glb = (const float*)(ws + WS_SSY) + hv * 256 + wi * GD_WCH;
    bf16_t* ob = (bf16_t*)(ws + WS_RB) + (size_t)(wi * GD_WCH * 64) * 4096 + 2048 + hv * 128 + slice * 16 + fr;
    { const unsigned want = (wi == 0) ? gridDim.x : gridDim.x - 128; unsigned sp = 0;
      while (__hip_atomic_load(flags + 64 * wi, __ATOMIC_RELAXED, __HIP_MEMORY_SCOPE_AGENT) < want) { __builtin_amdgcn_s_sleep(2); if (++sp > (1u << 22)) break; }
      __builtin_amdgcn_fence(__ATOMIC_ACQUIRE, "agent"); asm volatile("s_waitcnt vmcnt(0)" ::: "memory"); }
#ifndef GS2_DIRECT
    GS2_STAGE(0, 0);
#endif
    GS2_LDU(ucur, 0);
    asm volatile("s_waitcnt vmcnt(0)" ::: "memory");
    for (int nl = 0; nl < GD_WCH; ++nl) {
        asm volatile("s_waitcnt lgkmcnt(0)" ::: "memory");
#ifdef GS2_DIRECT
        if (nl + 1 < GD_WCH) { GS2_LDU(unxt, nl + 1); }
#else
        if (nl + 1 < GD_WCH) { GS2_STAGE((nl + 1) & 1, nl + 1); GS2_LDU(unxt, nl + 1); }
#endif
        const float egl = glb[nl];
#ifdef GS2_DIRECT
        const unsigned char* sb = items + (size_t)nl * GD_ITEM + lane * 16;
#define GS2_FR(off) (*(const bf16x8*)(sb + (off)))
#else
        const LAS unsigned char* sb = lds + (nl & 1) * GD_STEP + lane * 16;
#define GS2_FR(off) (*(const LAS bf16x8*)(sb + (off)))
#endif
        f32x4 vn[4];
#pragma unroll
        for (int mt = 0; mt < 4; ++mt) { f32x4 a = z4;
#pragma unroll
            for (int kk = 0; kk < 4; ++kk) a = MFMA16(GS2_FR(GD_W + (mt * 4 + kk) * 1024), Sop[kk], a);
            vn[mt] = ucur[mt] - a; }
        bf16x8 Vop[2]; Vop[0] = pack8(vn[0], vn[1]); Vop[1] = pack8(vn[2], vn[3]);
#pragma unroll
        for (int mt = 0; mt < 4; ++mt) { f32x4 a = z4;
#pragma unroll
            for (int kk = 0; kk < 4; ++kk) a = MFMA16(GS2_FR(GD_QD + (mt * 4 + kk) * 1024), Sop[kk], a);
#pragma unroll
            for (int k2 = 0; k2 < 2; ++k2) a = MFMA16(GS2_FR(GD_QK + (mt * 2 + k2) * 1024), Vop[k2], a);
            a = a * one;
#pragma unroll
            for (int jj = 0; jj < 4; ++jj) ob[(size_t)(nl * 64 + 16 * mt + 4 * fq + jj) * 4096] = (bf16_t)(cvt_pk_bf16(a[jj], a[jj]) & 0xffffu); }
#pragma unroll
        for (int dt = 0; dt < 8; ++dt) { f32x4 a = Sacc[dt] * egl;
#pragma unroll
            for (int k2 = 0; k2 < 2; ++k2) a = MFMA16(GS2_FR(GD_KDT + (dt * 2 + k2) * 1024), Vop[k2], a);
            Sacc[dt] = a; }
#pragma unroll
        for (int kk = 0; kk < 4; ++kk) Sop[kk] = pack8(Sacc[2 * kk] * one, Sacc[2 * kk + 1] * one);
        asm volatile("s_waitcnt vmcnt(0)" ::: "memory");
#pragma unroll
        for (int mt = 0; mt < 4; ++mt) ucur[mt] = unxt[mt];
    }
    if (lane == 0) (void)__hip_atomic_fetch_add(flags + 64 * (8 + wi), 1u, __ATOMIC_RELAXED, __HIP_MEMORY_SCOPE_AGENT);
    }
#undef GS2_STAGE
#undef GS2_LDU
}

__device__ __forceinline__ void gdn_prep_pipe(KP P, int li, LAS unsigned char* lds) {
    for (int w = 0; w < GD_NWIN; ++w) {
        if (w > 0 && (int)blockIdx.x < 128) break;
        unsigned* flags = (unsigned*)(lau(lau(P)->ws) + WS_XBAR + 16384) + (size_t)li * 16 * 64;
        if (w >= 2) { if (laus(my_wave(lds)) == 0 && lauv(my_lane()) == 0) { unsigned sp = 0;
                while (__hip_atomic_load(flags + 64 * (8 + w - 2), __ATOMIC_RELAXED, __HIP_MEMORY_SCOPE_AGENT) < 128u) { __builtin_amdgcn_s_sleep(2); if (++sp > (1u << 22)) break; } }
            __syncthreads(); }
        gdn_prep_phase(P, w, lds, w == 0 ? 0 : 128, w == 0 ? (int)gridDim.x : (int)gridDim.x - 128);
        asm volatile("s_waitcnt vmcnt(0)" ::: "memory");
        __syncthreads();
        if (laus(my_wave(lds)) == 0 && lauv(my_lane()) == 0) { __builtin_amdgcn_fence(__ATOMIC_RELEASE, "agent"); asm volatile("s_waitcnt vmcnt(0)" ::: "memory");
            (void)__hip_atomic_fetch_add(flags + 64 * w, 1u, __ATOMIC_RELAXED, __HIP_MEMORY_SCOPE_AGENT); }
    }
}

__device__ __forceinline__ void gdn_sso_phase(KP P, LAS unsigned char* lds) {
    P = lau(P);
    const int lane = lauv(my_lane()), wave = laus(my_wave(lds)), ngw = gridDim.x * NWAVES, gw = blockIdx.x * NWAVES + wave;
    unsigned char* ws = lau(P->ws); const bf16_t* o = (const bf16_t*)(ws + WS_RB) + 2048; float* sso = (float*)(ws + WS_SSO);
    for (int r = gw; r < T; r += ngw) {
        float s = 0.f;
#pragma unroll
        for (int j = 0; j < 8; ++j) { const f32x4 v = ld_bf4(o + (size_t)r * 4096 + 32 * lane + 4 * j); s += (v[0] * v[0] + v[1] * v[1]) + (v[2] * v[2] + v[3] * v[3]); }
        s += dpp_f<0xB1>(s); s += dpp_f<0x4E>(s);
        if ((lane & 3) == 0) sso[r * 16 + (lane >> 2)] = s;
    }
}
__device__ __forceinline__ void ssh2_reduce_phase(KP P, LAS unsigned char* lds) {
    P = lau(P);
    const int lane = lauv(my_lane()), wave = laus(my_wave(lds));
    unsigned char* ws = lau(P->ws); const float* part = (const float*)(ws + WS_SSH2P); float* ssh2 = (float*)(ws + WS_SSH2);
    const int r = (blockIdx.x * NWAVES + wave) * 64 + lane;
    if (r < T) { f32x4 a = *(const f32x4*)(part + (size_t)r * 16), b = *(const f32x4*)(part + (size_t)r * 16 + 4), c = *(const f32x4*)(part + (size_t)r * 16 + 8), d = *(const f32x4*)(part + (size_t)r * 16 + 12);
        a = (a + b) + (c + d); ssh2[r] = (a[0] + a[1]) + (a[2] + a[3]); }
}


__device__ __forceinline__ void nsa_item(KP P, int g, int tb, LAS unsigned char* wl, int lane) {
    const int fr = lane & 15, fq = lane >> 4, t0 = tb * 16, tq = t0 + fr;
    unsigned char* ws = lau(lau(P)->ws);
    const bf16_t* qb = (const bf16_t*)(ws + WS_RA);
    bf16_t* ob = (bf16_t*)(ws + WS_RA + 64 * MiB);
    const bf16_t* kbuf = (const bf16_t*)(ws + WS_RB + RB_KBUF);
    const bf16_t* kslc = kbuf + ((size_t)(2 * 4 + g) * T) * 64; const bf16_t* kwin = kbuf + ((size_t)(3 * 4 + g) * T) * 64;
    const bf16_t* vT = (const bf16_t*)(ws + WS_RA + RA_VT);
    const bf16_t* vslcT = vT + (size_t)g * T * 64; const bf16_t* vwinT = vT + (size_t)(1 * 256 + g * 64) * VT_LD;
    const bf16_t* kc = (const bf16_t*)(ws + WS_RB + RB_KC) + (size_t)g * 1024 * 256;
    const bf16_t* vcT = (const bf16_t*)(ws + WS_RB + RB_VCT) + (size_t)g * 256 * 1024;
    LAS float* imp = (LAS float*)wl;
    LAS int* sel = (LAS int*)(wl + 16448);
    const int krow = 8 * (fr >> 2) + (fr & 3);
    const float zf = __builtin_bit_cast(float, lauv(0));
    const f32x4 z4 = (f32x4){zf, zf, zf, zf};

    for (int x = lane; x < 16 * 257; x += 64) imp[x] = 0.f;
    bf16x8 Q[4][2];
#pragma unroll
    for (int r = 0; r < 4; ++r)
#pragma unroll
        for (int kk = 0; kk < 2; ++kk) Q[r][kk] = ldg16(qb + (size_t)tq * 1280 + (g * 4 + r) * 64 + kk * 32 + fq * 8);

    const int nst = (tb + 31) >> 5;
    float mf[4], inv[4];
    {
        float m1[4], l1[4];
#pragma unroll
        for (int r = 0; r < 4; ++r) { m1[r] = -1e30f; l1[r] = 0.f; }
        for (int st = 0; st < nst; ++st) {
            bf16x8 K[2][2];
#pragma unroll
            for (int e = 0; e < 2; ++e)
#pragma unroll
                for (int kk = 0; kk < 2; ++kk) K[e][kk] = ldg16(kc + (size_t)(32 * st + krow + 4 * e) * 256 + kk * 32 + fq * 8);
#pragma unroll
            for (int r = 0; r < 4; ++r) {
                f32x4 s[2]; float mt = -1e30f;
#pragma unroll
                for (int e = 0; e < 2; ++e) { s[e] = MFMA16(K[e][0], Q[r][0], z4); s[e] = MFMA16(K[e][1], Q[r][1], s[e]);
#pragma unroll
                    for (int jj = 0; jj < 4; ++jj) { const int key = 32 * st + 8 * fq + 4 * e + jj; const bool vis = (16 * key + 31 <= tq); s[e][jj] = vis ? s[e][jj] : -1e30f; mt = fmaxf(mt, s[e][jj]); } }
                const float mn = fmaxf(m1[r], mt); float ls = 0.f;
#pragma unroll
                for (int e = 0; e < 2; ++e)
#pragma unroll
                    for (int jj = 0; jj < 4; ++jj) ls += (s[e][jj] > -1e29f) ? __expf(s[e][jj] - mn) : 0.f;
                l1[r] = l1[r] * __expf(m1[r] - mn) + ls; m1[r] = mn;
            }
        }
#pragma unroll
        for (int r = 0; r < 4; ++r) { float M = m1[r]; M = fmaxf(M, shx(M, 16, lane)); M = fmaxf(M, shx(M, 32, lane));
            float L = l1[r] * __expf(m1[r] - M); L += shx(L, 16, lane); L += shx(L, 32, lane);
            mf[r] = M; inv[r] = L > 0.f ? 1.f / L : 0.f; }
    }
    {
        f32x4 oc[4][4];
#pragma unroll
        for (int r = 0; r < 4; ++r)
#pragma unroll
            for (int dt = 0; dt < 4; ++dt) oc[r][dt] = z4;
        for (int st = 0; st < nst; ++st) {
            bf16x8 K[2][2], V[4];
#pragma unroll
            for (int e = 0; e < 2; ++e)
#pragma unroll
                for (int kk = 0; kk < 2; ++kk) K[e][kk] = ldg16(kc + (size_t)(32 * st + krow + 4 * e) * 256 + kk * 32 + fq * 8);
#pragma unroll
            for (int dt = 0; dt < 4; ++dt) V[dt] = ldg16(vcT + (size_t)(16 * dt + fr) * 1024 + 32 * st + 8 * fq);
            f32x4 ps[2]; ps[0] = z4; ps[1] = z4;
#pragma unroll
            for (int r = 0; r < 4; ++r) {
                f32x4 s[2];
#pragma unroll
                for (int e = 0; e < 2; ++e) { s[e] = MFMA16(K[e][0], Q[r][0], z4); s[e] = MFMA16(K[e][1], Q[r][1], s[e]);
#pragma unroll
                    for (int jj = 0; jj < 4; ++jj) { const int key = 32 * st + 8 * fq + 4 * e + jj; const bool vis = (16 * key + 31 <= tq); s[e][jj] = vis ? __expf(s[e][jj] - mf[r]) * inv[r] : 0.f; }
                    ps[e] += s[e]; }
                const bf16x8 Pm = pack8(s[0], s[1]);
#pragma unroll
                for (int dt = 0; dt < 4; ++dt) oc[r][dt] = MFMA16(V[dt], Pm, oc[r][dt]);
            }
            const int k0 = 8 * st + 2 * fq;
            const float a = 2.f * (ps[0][0] + ps[0][1] + ps[0][2]) + ps[0][3], b = ps[0][3] + 2.f * (ps[1][0] + ps[1][1] + ps[1][2]) + ps[1][3], c = ps[1][3];
            LAS float* ip = imp + fr * 257 + k0;
            ip[0] += a; ip[1] += b;
            asm volatile("" ::: "memory");
            if (k0 + 2 < 256) ip[2] += c;
            asm volatile("" ::: "memory");
        }
        asm volatile("s_waitcnt lgkmcnt(0)" ::: "memory");
        for (int i = 0; i < 16; ++i) {
            const int t = t0 + i, cur = t >> 6;
            unsigned key[4];
#pragma unroll
            for (int c = 0; c < 4; ++c) { const int k = lane + 64 * c; const float v = imp[i * 257 + k]; const bool valid = k <= cur, forced = (k == 0) || (k == cur) || (k == cur - 1);
                const unsigned bits = forced ? __float_as_uint(1e4f) : __float_as_uint(v); key[c] = valid ? ((bits & 0xFFFFFF00u) | (unsigned)(255 - k)) : 0u; }
            for (int n = 0; n < 16; ++n) {
                unsigned mx = umax_(umax_(key[0], key[1]), umax_(key[2], key[3]));
                mx = wave_max_u32(mx);
                if (lane == 0) sel[i * 16 + n] = mx ? (int)(255u - (mx & 255u)) : -1;
#pragma unroll
                for (int c = 0; c < 4; ++c) key[c] = (key[c] == mx) ? 0u : key[c];
            }
        }
        asm volatile("s_waitcnt lgkmcnt(0)" ::: "memory");
#pragma unroll
        for (int r = 0; r < 4; ++r) { const float g0 = sigmoidf_(bf2f(qb[(size_t)tq * 1280 + 1024 + (g * 4 + r) * 3 + 0]));
#pragma unroll
            for (int dt = 0; dt < 4; ++dt) *(LAS f32x4*)(imp + (fr * 4 + r) * 64 + 16 * dt + 4 * fq) = oc[r][dt] * g0; }
    }
    {
        f32x4 ow[4][4]; float mw[4], lw[4];
#pragma unroll
        for (int r = 0; r < 4; ++r) { mw[r] = -1e30f; lw[r] = 0.f;
#pragma unroll
            for (int dt = 0; dt < 4; ++dt) ow[r][dt] = z4; }
        const int lo = t0 - 511 > 0 ? t0 - 511 : 0, st_lo = lo >> 5, st_hi = (t0 + 15) >> 5;
        for (int st = st_lo; st <= st_hi; ++st) {
            bf16x8 K[2][2], V[4];
#pragma unroll
            for (int e = 0; e < 2; ++e)
#pragma unroll
                for (int kk = 0; kk < 2; ++kk) K[e][kk] = ldg16(kwin + (size_t)(32 * st + krow + 4 * e) * 64 + kk * 32 + fq * 8);
#pragma unroll
            for (int dt = 0; dt < 4; ++dt) V[dt] = ldg16(vwinT + (size_t)(16 * dt + fr) * VT_LD + 32 * st + 8 * fq);
#pragma unroll
            for (int r = 0; r < 4; ++r) {
                f32x4 s[2]; float mt = -1e30f;
#pragma unroll
                for (int e = 0; e < 2; ++e) { s[e] = MFMA16(K[e][0], Q[r][0], z4); s[e] = MFMA16(K[e][1], Q[r][1], s[e]);
#pragma unroll
                    for (int jj = 0; jj < 4; ++jj) { const int pos = 32 * st + 8 * fq + 4 * e + jj; const bool vis = (pos <= tq) && (pos > tq - 512); s[e][jj] = vis ? s[e][jj] : -1e30f; mt = fmaxf(mt, s[e][jj]); } }
                mt = fmaxf(mt, shx(mt, 16, lane)); mt = fmaxf(mt, shx(mt, 32, lane));
                const float mn = fmaxf(mw[r], mt), al = __expf(mw[r] - mn); mw[r] = mn; float ls = 0.f;
#pragma unroll
                for (int e = 0; e < 2; ++e)
#pragma unroll
                    for (int jj = 0; jj < 4; ++jj) { s[e][jj] = (s[e][jj] > -1e29f) ? __expf(s[e][jj] - mn) : 0.f; ls += s[e][jj]; }
                lw[r] = lw[r] * al + ls;
                const bf16x8 Pm = pack8(s[0], s[1]);
#pragma unroll
                for (int dt = 0; dt < 4; ++dt) { ow[r][dt] = ow[r][dt] * al; ow[r][dt] = MFMA16(V[dt], Pm, ow[r][dt]); }
            }
        }
#pragma unroll
        for (int r = 0; r < 4; ++r) { float L = lw[r]; L += shx(L, 16, lane); L += shx(L, 32, lane);
            const float sc = sigmoidf_(bf2f(qb[(size_t)tq * 1280 + 1024 + (g * 4 + r) * 3 + 2])) / L;
#pragma unroll
            for (int dt = 0; dt < 4; ++dt) { LAS f32x4* cp = (LAS f32x4*)(imp + (fr * 4 + r) * 64 + 16 * dt + 4 * fq); *cp = *cp + ow[r][dt] * sc; } }
    }
    asm volatile("s_waitcnt lgkmcnt(0)" ::: "memory");
    for (int i = 0; i < 16; ++i) {
        const int t = t0 + i;
        bf16x8 Qs[2];
#pragma unroll
        for (int kk = 0; kk < 2; ++kk) { Qs[kk] = ldg16(qb + (size_t)t * 1280 + (g * 4 + (fr & 3)) * 64 + kk * 32 + fq * 8); if (fr >= 4) Qs[kk] = (bf16x8){0, 0, 0, 0, 0, 0, 0, 0}; }
        f32x4 os[4]; float ms = -1e30f, lsum = 0.f;
#pragma unroll
        for (int dt = 0; dt < 4; ++dt) os[dt] = z4;
        int nv = 0;
        for (int n = 0; n < 16; ++n) nv += (__builtin_amdgcn_readfirstlane(sel[i * 16 + n]) >= 0) ? 1 : 0;
#define SEL_LOAD(K_, V_, kb_) do { _Pragma("unroll") for (int e = 0; e < 2; ++e) _Pragma("unroll") for (int kk = 0; kk < 2; ++kk) K_[e][kk] = ldg16(kslc + (size_t)((kb_) >> 5) * 2048 + ((e * 2 + kk) * 64 + lane) * 8); \
        _Pragma("unroll") for (int dt = 0; dt < 4; ++dt) V_[dt] = ldg16(vslcT + (size_t)((kb_) >> 5) * 2048 + (dt * 64 + lane) * 8); } while (0)
#define SEL_COMP64(kb_, FULL_) do { f32x4 s[4]; float mt = -1e30f; \
        _Pragma("unroll") for (int e = 0; e < 2; ++e) { s[e] = MFMA16(KA[e][0], Qs[0], z4); s[e] = MFMA16(KA[e][1], Qs[1], s[e]); s[2 + e] = MFMA16(KB[e][0], Qs[0], z4); s[2 + e] = MFMA16(KB[e][1], Qs[1], s[2 + e]); } \
        _Pragma("unroll") for (int q = 0; q < 4; ++q) _Pragma("unroll") for (int jj = 0; jj < 4; ++jj) { const int pos = (kb_) + 32 * (q >> 1) + 8 * fq + 4 * (q & 1) + jj; const float sv = s[q][jj] * 1.44269504f; \
            s[q][jj] = (FULL_ || pos <= t) ? sv : -1e30f; mt = fmaxf(mt, s[q][jj]); } \
        mt = fmaxf(mt, shx(mt, 16, lane)); mt = fmaxf(mt, shx(mt, 32, lane)); \
        const float mn = fmaxf(ms, mt); float ls = 0.f; \
        if (__builtin_amdgcn_ballot_w64(mn > ms) != 0ull) { const float al = __builtin_amdgcn_exp2f(ms - mn); lsum *= al; _Pragma("unroll") for (int dt = 0; dt < 4; ++dt) os[dt] = os[dt] * al; } \
        ms = mn; \
        _Pragma("unroll") for (int q = 0; q < 4; ++q) _Pragma("unroll") for (int jj = 0; jj < 4; ++jj) { const float pv = __builtin_amdgcn_exp2f(s[q][jj] - mn); s[q][jj] = (FULL_ || s[q][jj] > -1e29f) ? pv : 0.f; ls += s[q][jj]; } \
        lsum += ls; \
        const bf16x8 PmA = pack8(s[0], s[1]), PmB = pack8(s[2], s[3]); \
        _Pragma("unroll") for (int dt = 0; dt < 4; ++dt) { os[dt] = MFMA16(VA[dt], PmA, os[dt]); os[dt] = MFMA16(VB[dt], PmB, os[dt]); } } while (0)
        bf16x8 KA[2][2], VA[4], KB[2][2], VB[4];
        for (int n = 0; n < nv; ++n) {
            const int b = __builtin_amdgcn_readfirstlane(sel[i * 16 + n]);
            SEL_LOAD(KA, VA, b * 64); SEL_LOAD(KB, VB, b * 64 + 32);
            if (b < (t >> 6)) { SEL_COMP64(b * 64, true); }
            else { SEL_COMP64(b * 64, false); }
        }
#undef SEL_LOAD
#undef SEL_COMP64
        float L = lsum; L += shx(L, 16, lane); L += shx(L, 32, lane);
        if (fr < 4) {
            const float sc = sigmoidf_(bf2f(qb[(size_t)t * 1280 + 1024 + (g * 4 + fr) * 3 + 1])) / L;
#pragma unroll
            for (int dt = 0; dt < 4; ++dt) { const f32x4 cb = *(const LAS f32x4*)(imp + (i * 4 + fr) * 64 + 16 * dt + 4 * fq);
                st_bf4(ob + (size_t)t * 1024 + (g * 4 + fr) * 64 + 16 * dt + 4 * fq, cb + os[dt] * sc); }
        }
    }
    asm volatile("s_waitcnt lgkmcnt(0)" ::: "memory");
}
__device__ __forceinline__ void nsa_attn_phase(KP P, LAS unsigned char* lds) {
    P = lau(P);
    const int lane = lauv(my_lane()), wave = laus(my_wave(lds)), ngw = gridDim.x * NWAVES, gw = blockIdx.x * NWAVES + wave;
    LAS unsigned char* wl = lds + wave * NSA_WAVE_LDS;
    for (int it = gw; it < 2048; it += ngw) {
        int g = it & 3, tb = it >> 2;
        if (gridDim.x == 256) { const int bxx = blockIdx.x; g = (bxx & 7) >> 1; tb = (((bxx >> 3) * 2 + (bxx & 1)) * NWAVES) + wave; }
        for (int half = 0; half < 2; ++half) nsa_item(P, g, half ? 1023 - tb : tb, wl, lane);
    }
}

__global__ void __launch_bounds__(NTHREADS, 2) fwd_megakernel(Params P_arg) {
    KP P = (KP)__builtin_amdgcn_kernarg_segment_ptr();
    extern __shared__ __attribute__((aligned(16))) unsigned char lds_raw[];
    LAS unsigned char* lds = (LAS unsigned char*)lds_raw;
    { const int tid0 = threadIdx.x; if ((tid0 & 63) == 0) ((LAS int*)(lds + LDS_TBL))[hw_slot()] = tid0 >> 6;
      if (tid0 < 2) ((LAS unsigned*)(lds + LDS_XB))[tid0] = 0u;
      if (tid0 == 0) (void)xb_add((unsigned*)(lau(lau(P)->ws) + WS_XBAR) + XB_XCNT(xb_xcc_id()), 1u); }
    __syncthreads();
#define G ((int)gridDim.x)
#define bx ((int)blockIdx.x)
    using pg8::Gemm; using pg8::StaticOrder; using pg8::gemm_phase; using pg8::EpiFn; using pg8::EpiSS;
#define RUN_GEMM(gm, Mm, Nn, cc, epi) do { StaticOrder S_; S_.init((Mm), (Nn), laus((int)gridDim.x), laus((int)(cc))); gemm_phase(lds, (gm), S_, (epi)); } while (0)
#define HB_CUR(ws_, li_) ((bf16_t*)((ws_) + (((li_) & 1) ? WS_HBB : WS_HBA)))
#define HB_NXT(ws_, li_) ((bf16_t*)((ws_) + (((li_) & 1) ? WS_HBA : WS_HBB)))

    rows_phase(P, 0, 0, (bf16_t*)(lau(lau(P)->ws) + WS_HBA), nullptr, nullptr, lds);
    convert_layer(P, 0, lds);
    GRID_SYNC();
    if (laus(my_wave(lds)) == 0 && lauv(my_lane()) == 0) { unsigned nloc, nx; xcd_barrier_complete((unsigned*)(lau(lau(P)->ws) + WS_XBAR), xb_xcc_id(), nloc, nx); ((LAS unsigned*)(lds + LDS_XB))[0] = nloc; ((LAS unsigned*)(lds + LDS_XB))[1] = nx; }
    __syncthreads();

    for (int li = 0; li < 4; ++li) {
        if (li > 0) { ssh2_reduce_phase(P, lds); convert_layer(P, li, lds); if (li == 2) cmp_bias(P, lds); xcd_grid_barrier(P, lds); }
        if (li < 2) {
            { unsigned char* ws = lau(lau(P)->ws); const float* ssh2 = (const float*)(ws + WS_SSH2); float* bg = (float*)(ws + WS_BG); bf16_t* RA = (bf16_t*)(ws + WS_RA);
              Gemm gm{HB_CUR(ws, li), (const bf16_t*)(ws + WS_W + W_WIN), T, 4352, D, D, D};
              auto E_l = [=](int row, int cb, const f32x4& v0, const f32x4& v1) { const float rs = rsqrtf(ssh2[row] * (1.f / D) + EPS);
                  if (cb < 4096) { st_bf4(RA + (size_t)row * 4096 + cb, v0 * rs); st_bf4(RA + (size_t)row * 4096 + cb + 16, v1 * rs); }
                  else if (cb < 4128) { const int c = cb - 4096; if (c < 16) { *(f32x4*)(bg + (size_t)row * 32 + c) = v0 * rs; *(f32x4*)(bg + (size_t)row * 32 + c + 16) = v1 * rs; } } };
              EpiFn<decltype(E_l)> E{E_l};
              RUN_GEMM(gm, T, 4352, bx, E); }
            xcd_grid_barrier(P, lds);
            gdn_conv_phase(P, li, lds);
            xcd_grid_barrier(P, lds);
#ifdef GDN_NAIVE
            gdn_scan_phase(P, lds);
            xcd_grid_barrier(P, lds);
#else
            gdn_prep_pipe(P, li, lds);
            gdn_scan2_phase(P, li, lds);
            xcd_grid_barrier(P, lds);
#endif
            gdn_sso_phase(P, lds);
            xcd_grid_barrier(P, lds);
            { unsigned char* ws = lau(lau(P)->ws); const float* ssh2 = (const float*)(ws + WS_SSH2); const float* sso = (const float*)(ws + WS_SSO); bf16_t* RB = (bf16_t*)(ws + WS_RB);
              Gemm gm{HB_CUR(ws, li), (const bf16_t*)(ws + WS_W + W_WZ), T, 2048, D, D, D};
              const float* onorm = lau(lau(P)->gdn_o_norm) + li * 128;
              auto E_l = [=](int row, int cb, const f32x4& v0, const f32x4& v1) { const float rs = rsqrtf(ssh2[row] * (1.f / D) + EPS);
                  const float rr = rsqrtf(sso[row * 16 + (cb >> 7)] * (1.f / 128.f) + EPS);
                  bf16_t* op = RB + (size_t)row * 4096 + 2048 + cb;
#pragma unroll
                  for (int h = 0; h < 2; ++h) { const f32x4 z = (h ? v1 : v0) * rs; const f32x4 o = ld_bf4(op + 16 * h); const f32x4 gn = *(const f32x4*)(onorm + ((cb + 16 * h) & 127)); f32x4 r;
#pragma unroll
                      for (int e = 0; e < 4; ++e) r[e] = o[e] * rr * gn[e] * siluf_(z[e]);
                      st_bf4(op + 16 * h, r); } };
              EpiFn<decltype(E_l)> E{E_l};
              RUN_GEMM(gm, T, 2048, bx, E); }
            xcd_grid_barrier(P, lds);
            { unsigned char* ws = lau(lau(P)->ws);
              Gemm gm{(const bf16_t*)(ws + WS_RB) + 2048, (const bf16_t*)(ws + WS_W + W_WOUT), T, D, 2048, 4096, 2048};
              auto gl = [=](int, int, f32x4&, f32x4&) {}; EpiSS<decltype(gl)> E{gl, (float*)(ws + WS_RA), (float*)(ws + WS_SSYP), D};
              RUN_GEMM(gm, T, D, bx, E); }
            xcd_grid_barrier(P, lds);
        } else {
            { unsigned char* ws = lau(lau(P)->ws); const float* ssh2 = (const float*)(ws + WS_SSH2); bf16_t* RA = (bf16_t*)(ws + WS_RA);
              Gemm gm{HB_CUR(ws, li), (const bf16_t*)(ws + WS_W + W_WQ), T, 1280, D, D, D};
              auto E_l = [=](int row, int cb, const f32x4& v0, const f32x4& v1) { const float rs = rsqrtf(ssh2[row] * (1.f / D) + EPS);
                  st_bf4(RA + (size_t)row * 1280 + cb, v0 * rs); st_bf4(RA + (size_t)row * 1280 + cb + 16, v1 * rs); };
              EpiFn<decltype(E_l)> E{E_l};
              RUN_GEMM(gm, T, 1280, bx, E); }
            if (li == 2) {
                { unsigned char* ws = lau(lau(P)->ws); const float* ssh2 = (const float*)(ws + WS_SSH2); bf16_t* kbuf = (bf16_t*)(ws + WS_RB + RB_KBUF);
                  Gemm gm{HB_CUR(ws, li), (const bf16_t*)(ws + WS_W + W_WK), T, 1024, D, D, D};
                  auto E_l = [=](int row, int cb, const f32x4& v0, const f32x4& v1) { const float rs = rsqrtf(ssh2[row] * (1.f / D) + EPS);
                      const int gi = cb >> 6, d0 = cb & 63;
                      if ((gi >> 2) == 2) {
                          const int k5 = row & 31, fr_ = ((k5 >> 3) << 2) | (k5 & 3), e_ = (k5 >> 2) & 1;
                          bf16_t* hb = kbuf + (size_t)gi * T * 64 + (size_t)(row >> 5) * 2048;
                          const int d1 = d0 + 16;
                          st_bf4(hb + ((e_ * 2 + (d0 >> 5)) * 64 + ((d0 >> 3) & 3) * 16 + fr_) * 8 + (d0 & 4), v0 * rs);
                          st_bf4(hb + ((e_ * 2 + (d1 >> 5)) * 64 + ((d1 >> 3) & 3) * 16 + fr_) * 8 + (d1 & 4), v1 * rs);
                      } else { bf16_t* dp = kbuf + ((size_t)gi * T + row) * 64 + d0; st_bf4(dp, v0 * rs); st_bf4(dp + 16, v1 * rs); } };
                  EpiFn<decltype(E_l)> E{E_l};
                  RUN_GEMM(gm, T, 1024, (bx + 64) % G, E); }
                { unsigned char* ws = lau(lau(P)->ws); const float* ssh2 = (const float*)(ws + WS_SSH2); bf16_t* vT = (bf16_t*)(ws + WS_RA + RA_VT);
                  Gemm gm{(const bf16_t*)(ws + WS_W + W_WV), HB_CUR(ws, li), 512, T, D, D, D};
                  auto E_l = [=](int row, int cb, const f32x4& v0, const f32x4& v1) {
#pragma unroll
                      for (int h = 0; h < 2; ++h) { const int c = cb + 16 * h; const f32x4 ss4 = *(const f32x4*)(ssh2 + c); f32x4 v = h ? v1 : v0;
#pragma unroll
                          for (int e = 0; e < 4; ++e) v[e] *= rsqrtf(ss4[e] * (1.f / D) + EPS);
                          if (row < 256) {
                              const int g_ = row >> 6, d_ = row & 63;
                              st_bf4(vT + (size_t)g_ * T * 64 + (size_t)(c >> 5) * 2048 + ((d_ >> 4) * 64 + ((c & 31) >> 3) * 16 + (d_ & 15)) * 8 + (c & 4), v);
                          } else st_bf4(vT + (size_t)row * VT_LD + c, v); } };
                  EpiFn<decltype(E_l)> E{E_l};
                  RUN_GEMM(gm, 512, T, (bx + 128) % G, E); }
                xcd_grid_barrier(P, lds);
                for (int idx = 0; idx < 2; ++idx) {
                    unsigned char* ws = lau(lau(P)->ws);
                    Gemm gm{(const bf16_t*)(ws + WS_RB + RB_KBUF) + (size_t)idx * 4 * T * 64, (const bf16_t*)(ws + WS_W + W_W1T) + (size_t)idx * 256 * 2048, 4096, 256, 2048, 1024, 2048};
                    bf16_t* hd = (bf16_t*)(ws + WS_RB + RB_HID) + (size_t)idx * 4096 * 256; const float* b1 = (const float*)(ws + WS_BIAS1) + idx * 256;
                    auto E_l = [=](int row, int cb, const f32x4& v0, const f32x4& v1) {
#pragma unroll
                        for (int h = 0; h < 2; ++h) { const int c = cb + 16 * h; f32x4 v = (h ? v1 : v0) + *(const f32x4*)(b1 + c);
#pragma unroll
                            for (int e = 0; e < 4; ++e) v[e] = siluf_(v[e]);
                            st_bf4(hd + (size_t)row * 256 + c, v); } };
                    EpiFn<decltype(E_l)> E{E_l};
                    RUN_GEMM(gm, 4096, 256, (bx + 128 * idx) % G, E);
                }
                xcd_grid_barrier(P, lds);
                { unsigned char* ws = lau(lau(P)->ws); bf16_t* kcb = (bf16_t*)(ws + WS_RB + RB_KC);
                  Gemm gm{(const bf16_t*)(ws + WS_RB + RB_HID), (const bf16_t*)(ws + WS_W + W_W2T), 4096, 256, 256, 256, 256};
                  auto E_l = [=](int row, int cb, const f32x4& v0, const f32x4& v1) { const float zz = ((row & 1023) == 1023) ? 0.f : 1.f; st_bf4(kcb + (size_t)row * 256 + cb, v0 * zz); st_bf4(kcb + (size_t)row * 256 + cb + 16, v1 * zz); };
                  EpiFn<decltype(E_l)> E{E_l};
                  RUN_GEMM(gm, 4096, 256, bx, E); }
                { unsigned char* ws = lau(lau(P)->ws); bf16_t* vct = (bf16_t*)(ws + WS_RB + RB_VCT);
                  Gemm gm{(const bf16_t*)(ws + WS_W + W_W2T) + (size_t)256 * 256, (const bf16_t*)(ws + WS_RB + RB_HID) + (size_t)4096 * 256, 256, 4096, 256, 256, 256};
                  auto E_l = [=](int row, int cb, const f32x4& v0, const f32x4& v1) {
#pragma unroll
                      for (int h = 0; h < 2; ++h) { const int c = cb + 16 * h; f32x4 v = h ? v1 : v0; v[3] = ((c & 1023) == 1020) ? 0.f : v[3];
                          st_bf4(vct + ((size_t)((c >> 10) * 256 + row)) * 1024 + (c & 1023), v); } };
                  EpiFn<decltype(E_l)> E{E_l};
                  RUN_GEMM(gm, 256, 4096, (bx + 128) % G, E); }
            }
            xcd_grid_barrier(P, lds);
#ifdef DBG_SKIP_NSA
            { unsigned char* ws = lau(lau(P)->ws); const int lane = lauv(my_lane()), wave = laus(my_wave(lds)); const bf16_t* qb = (const bf16_t*)(ws + WS_RA); bf16_t* ob = (bf16_t*)(ws + WS_RA + 64 * MiB);
              for (int r = bx * NWAVES + wave; r < T; r += G * NWAVES) for (int j = 0; j < 4; ++j) *(u32x2*)(ob + (size_t)r * 1024 + 4 * lane + 256 * j) = *(const u32x2*)(qb + (size_t)r * 1280 + 4 * lane + 256 * j); }
#else
            nsa_attn_phase(P, lds);
#endif
            xcd_grid_barrier(P, lds);
            { unsigned char* ws = lau(lau(P)->ws);
              Gemm gm{(const bf16_t*)(ws + WS_RA + 64 * MiB), (const bf16_t*)(ws + WS_W + W_WO), T, D, D, D, D};
              auto gl = [=](int, int, f32x4&, f32x4&) {}; EpiSS<decltype(gl)> E{gl, (float*)(ws + WS_RB + RB_Y), (float*)(ws + WS_SSYP), D};
              RUN_GEMM(gm, T, D, bx, E); }
            xcd_grid_barrier(P, lds);
        }
        { unsigned char* ws = lau(lau(P)->ws);
          rows_phase(P, 1, li, HB_CUR(ws, li), lau(lau(P)->mix_post) + li * D, (li < 2) ? (const float*)(ws + WS_RA) : (const float*)(ws + WS_RB + RB_Y), lds); }
        xcd_grid_barrier(P, lds);
        { unsigned char* ws = lau(lau(P)->ws); const float* ssh1 = (const float*)(ws + WS_SSH1); bf16_t* RA = (bf16_t*)(ws + WS_RA);
          Gemm gm{HB_CUR(ws, li), (const bf16_t*)(ws + WS_W + W_FFNIN), T, 2 * FF, D, D, D};
          auto E_l = [=](int row, int cb, const f32x4& v0, const f32x4& v1) { const float rs = rsqrtf(ssh1[row] * (1.f / D) + EPS);
              const int pn = cb >> 8, r = cb & 255, hidc = 128 * pn + 64 * (r >> 7) + 16 * ((r & 127) >> 5) + (r & 15);
              f32x4 o;
#pragma unroll
              for (int e = 0; e < 4; ++e) o[e] = siluf_(v0[e] * rs) * (v1[e] * rs);
              st_bf4(RA + (size_t)row * FF + hidc, o); };
          EpiFn<decltype(E_l)> E{E_l};
          RUN_GEMM(gm, T, 2 * FF, bx, E); }
        xcd_grid_barrier(P, lds);
        { unsigned char* ws = lau(lau(P)->ws);
          Gemm gm{(const bf16_t*)(ws + WS_RA), (const bf16_t*)(ws + WS_W + W_FFNOUT), T, D, FF, FF, FF};
          auto gl = [=](int, int, f32x4&, f32x4&) {}; EpiSS<decltype(gl)> E{gl, (float*)(ws + WS_RB + RB_Y), (float*)(ws + WS_SSYP), D};
          RUN_GEMM(gm, T, D, bx, E); }
        xcd_grid_barrier(P, lds);
        { unsigned char* ws = lau(lau(P)->ws);
          rows_phase(P, 2, li, HB_CUR(ws, li), lau(lau(P)->ffn_post) + li * D, (const float*)(ws + WS_RB + RB_Y), lds); }
        xcd_grid_barrier(P, lds);
        { unsigned char* ws = lau(lau(P)->ws); float* t1 = (float*)(ws + WS_RA);
          Gemm gm{(const bf16_t*)(ws + WS_RB + RB_PB), (const bf16_t*)(ws + WS_W + W_PLE), T, D, PLE, PLE, PLE};
          auto E_l = [=](int row, int cb, const f32x4& v0, const f32x4& v1) { *(f32x4*)(t1 + (size_t)row * D + cb) = v0; *(f32x4*)(t1 + (size_t)row * D + cb + 16) = v1; };
          EpiFn<decltype(E_l)> E{E_l};
          RUN_GEMM(gm, T, D, bx, E); }
        asm volatile("s_waitcnt vmcnt(0)" ::: "memory");
        { unsigned char* ws = lau(lau(P)->ws); const float* t1 = (const float*)(ws + WS_RA); bf16_t* hbn = HB_NXT(ws, li);
          Gemm gm{HB_CUR(ws, li), (const bf16_t*)(ws + WS_W + W_GATE), T, D, D, D, D};
          float* hout = lau(lau(P)->out);
          auto gl = [=](int row, int cb, f32x4& o0, f32x4& o1) {
#pragma unroll
              for (int h = 0; h < 2; ++h) { const int c = cb + 16 * h; f32x4& o = h ? o1 : o0; const f32x4 tt = *(const f32x4*)(t1 + (size_t)row * D + c), h0 = *(const f32x4*)(hout + (size_t)row * D + c);
#pragma unroll
                  for (int e = 0; e < 4; ++e) o[e] = h0[e] + tt[e] * sigmoidf_(o[e]);
                  st_bf4(hbn + (size_t)row * D + c, o); } };
          EpiSS<decltype(gl)> E{gl, hout, (float*)(ws + WS_SSH2P), D};
          RUN_GEMM(gm, T, D, bx, E); }
        xcd_grid_barrier(P, lds);
    }
}

extern "C" void kernel_launch(void* const* d_in, const int* in_sizes, int n_in, void* d_out, int out_size, void* d_ws, size_t ws_size, hipStream_t stream) {
    static int grid = 0;
    if (grid == 0) {
        if (n_in != 23 || out_size != T * D || ws_size < WS_END) { fprintf(stderr, "kernel_launch: unexpected problem (n_in %d out %d ws %zu, need %zu)\n", n_in, out_size, ws_size, (size_t)WS_END); grid = -1; return; }
        int dev = 0, cus = 0, per_cu = 0;
        (void)hipGetDevice(&dev); (void)hipDeviceGetAttribute(&cus, hipDeviceAttributeMultiprocessorCount, dev);
        (void)hipFuncSetAttribute((const void*)fwd_megakernel, hipFuncAttributeMaxDynamicSharedMemorySize, LDS_BYTES);
        (void)hipOccupancyMaxActiveBlocksPerMultiprocessor(&per_cu, (const void*)fwd_megakernel, NTHREADS, LDS_BYTES);
        if (per_cu < 1) per_cu = 1;
        grid = cus;
        (void)hipGetLastError();
        fprintf(stderr, "kernel_launch: grid %d (cus %d, per_cu %d), ws %zu\n", grid, cus, per_cu, ws_size);
    }
    if (grid < 0) return;
    Params prm{};
    const float** pp = (const float**)&prm;
    for (int i = 0; i < 23; ++i) pp[i] = (const float*)d_in[i];
    prm.out = (float*)d_out; prm.ws = (unsigned char*)d_ws;
    (void)hipMemsetAsync((unsigned char*)d_ws + WS_XBAR, 0, 32768, stream);
    void* args[] = {&prm};
    hipError_t e = hipLaunchCooperativeKernel((const void*)fwd_megakernel, dim3(grid), dim3(NTHREADS), args, LDS_BYTES, stream);
    if (e != hipSuccess) fprintf(stderr, "cooperative launch failed: %s (grid %d)\n", hipGetErrorString(e), grid);
}
```
